# Optimizing an MI355X kernel written in HIP

```python
import math
import jax, jax.numpy as jnp
from jax import lax
import numpy as np

D_MODEL = 1024
BATCH = 4
SEQ = 8192
DEPTH = 1

N_META = 16
CHUNK = 128
META_PAD = (-N_META) % CHUNK
RET_HEADS = 8
RET_DK = 64
RET_DV = 128
RET_QK_W = RET_HEADS * RET_DK
RET_V_W = RET_HEADS * RET_DV
MLA_HEADS = 8
MLA_Q_RANK = 384
MLA_KV_RANK = 256
MLA_NOPE = 64
MLA_ROPE = 32
MLA_DV = 64
MLA_QK = MLA_NOPE + MLA_ROPE
D_FF = ((-(-8 * D_MODEL // 3) + 255) // 256) * 256
ROPE_BASE = 10000.0
RMS_EPS = 1e-6
GN_EPS = 1e-5

SPLIT_SIZES = (RET_QK_W, RET_QK_W, RET_V_W, RET_V_W, MLA_Q_RANK, MLA_KV_RANK, MLA_ROPE, D_MODEL, D_MODEL)
SPLIT_IDX = tuple(int(s) for s in np.cumsum(SPLIT_SIZES)[:-1])
D_IN = int(sum(SPLIT_SIZES))

kernel_name = "hybrid_retention_mla_gated_encoder"


def _rmsnorm(x, w):
    xf = x.astype(jnp.float32)
    y = xf * lax.rsqrt(jnp.mean(xf * xf, axis=-1, keepdims=True) + RMS_EPS)
    return (y * w.astype(jnp.float32)).astype(x.dtype)


def _rope_tables(pos, dim):
    half = dim // 2
    inv = ROPE_BASE ** (-jnp.arange(half, dtype=jnp.float32) / half)
    ang = pos.astype(jnp.float32)[:, None] * inv[None, :]
    return jnp.cos(ang), jnp.sin(ang)


def _apply_rope(x, cos, sin):
    half = x.shape[-1] // 2
    xf = x.astype(jnp.float32)
    x1, x2 = xf[..., :half], xf[..., half:]
    return jnp.concatenate([x1 * cos - x2 * sin, x1 * sin + x2 * cos], axis=-1).astype(x.dtype)


def _retention_dir(q, k, v, log_gamma, inclusive):
    B, Lp, H, dk = q.shape
    dv = v.shape[-1]
    n = Lp // CHUNK
    qc = q.reshape(B, n, CHUNK, H, dk)
    kc = k.reshape(B, n, CHUNK, H, dk)
    vc = v.reshape(B, n, CHUNK, H, dv)
    lg = log_gamma.astype(jnp.float32)
    idx = jnp.arange(CHUNK, dtype=jnp.float32)
    rel = idx[:, None] - idx[None, :]
    mask = rel >= 0 if inclusive else rel > 0
    dmask = jnp.exp(jnp.where(mask[None], lg[:, None, None] * rel[None], -jnp.inf)).astype(q.dtype)
    scores = jnp.einsum('bnihd,bnjhd->bnhij', qc, kc) * dmask
    inner = jnp.einsum('bnhij,bnjhe->bnihe', scores, vc)
    w_k = jnp.exp(lg[None, :] * (CHUNK - 1 - idx)[:, None]).astype(q.dtype)
    incr = jnp.einsum('bnjhd,jh,bnjhe->nbhde', kc, w_k, vc)
    g_chunk = jnp.exp(lg * CHUNK).astype(incr.dtype)[None, :, None, None]

    def step(state, u):
        return g_chunk * state + u, state

    state0 = jnp.zeros((B, H, dk, dv), incr.dtype)
    _, states_prev = lax.scan(step, state0, incr)
    w_q = jnp.exp(lg[None, :] * (idx + 1.0)[:, None]).astype(q.dtype)
    cross = jnp.einsum('bnihd,ih,nbhde->bnihe', qc, w_q, states_prev)
    return (inner + cross).reshape(B, Lp, H, dv)


def _bidir_retention(q, k, v, decay_f, decay_b):
    lg_f = -jnp.exp(decay_f.astype(jnp.float32))
    lg_b = -jnp.exp(decay_b.astype(jnp.float32))
    pad = ((0, 0), (META_PAD, 0), (0, 0), (0, 0))
    qp, kp, vp = jnp.pad(q, pad), jnp.pad(k, pad), jnp.pad(v, pad)
    fwd = _retention_dir(qp, kp, vp, lg_f, True)
    bwd = jnp.flip(_retention_dir(jnp.flip(qp, 1), jnp.flip(kp, 1), jnp.flip(vp, 1), lg_b, False), 1)
    return (fwd + bwd)[:, META_PAD:]


def _head_group_norm(y, w):
    B, L, H, dv = y.shape
    yf = y.astype(jnp.float32)
    mu = jnp.mean(yf, axis=-1, keepdims=True)
    var = jnp.mean(jnp.square(yf - mu), axis=-1, keepdims=True)
    yn = ((yf - mu) * lax.rsqrt(var + GN_EPS)).reshape(B, L, H * dv)
    return (yn * w.astype(jnp.float32)).astype(y.dtype)


def _mla_attention(q_nope, q_rope, k_nope, k_rope, v):
    B, L, H, _ = q_nope.shape
    Lp = L + META_PAD
    nb = Lp // CHUNK
    scale = MLA_QK ** -0.5

    def to_blocks(t):
        t = jnp.pad(t, ((0, 0), (META_PAD, 0), (0, 0), (0, 0)))
        return t.reshape(B, nb, CHUNK, H, t.shape[-1]).swapaxes(0, 1)

    def attend(qb):
        qn, qr = qb
        s = jnp.einsum('bqhd,bkhd->bhqk', qn, k_nope) + jnp.einsum('bqhr,bkr->bhqk', qr, k_rope)
        p = jax.nn.softmax(s.astype(jnp.float32) * scale, axis=-1).astype(v.dtype)
        return jnp.einsum('bhqk,bkhd->bqhd', p, v)

    out = lax.map(attend, (to_blocks(q_nope), to_blocks(q_rope)))
    return out.swapaxes(0, 1).reshape(B, Lp, H, MLA_DV)[:, META_PAD:]


def _mixer(u, w_in, decay_f, decay_b, gn_w, w_ret_out, q_norm_w, w_uq, kv_norm_w, w_uk, w_uv,
           w_mla_out, w_o, ret_cos, ret_sin, mla_cos, mla_sin):
    B, L, _ = u.shape
    proj = u @ w_in
    rq, rk, rv, rg, a_cq, a_ckv, a_kr, a_gret, a_gmla = jnp.split(proj, SPLIT_IDX, axis=-1)

    rq = _apply_rope(rq.reshape(B, L, RET_HEADS, RET_DK), ret_cos[:, None, :], ret_sin[:, None, :])
    rk = _apply_rope(rk.reshape(B, L, RET_HEADS, RET_DK), ret_cos[:, None, :], ret_sin[:, None, :]) * (RET_DK ** -0.5)
    rv = rv.reshape(B, L, RET_HEADS, RET_DV)
    y_ret = _head_group_norm(_bidir_retention(rq, rk, rv, decay_f, decay_b), gn_w)
    y_ret = (jax.nn.silu(rg) * y_ret) @ w_ret_out

    c_q = _rmsnorm(a_cq, q_norm_w)
    q = (c_q @ w_uq).reshape(B, L, MLA_HEADS, MLA_QK)
    q_nope = q[..., :MLA_NOPE]
    q_rope = _apply_rope(q[..., MLA_NOPE:], mla_cos[:, None, :], mla_sin[:, None, :])
    c_kv = _rmsnorm(a_ckv, kv_norm_w)
    k_nope = (c_kv @ w_uk).reshape(B, L, MLA_HEADS, MLA_NOPE)
    v = (c_kv @ w_uv).reshape(B, L, MLA_HEADS, MLA_DV)
    k_rope = _apply_rope(a_kr, mla_cos, mla_sin)
    y_mla = _mla_attention(q_nope, q_rope, k_nope, k_rope, v).reshape(B, L, MLA_HEADS * MLA_DV) @ w_mla_out

    merged = jax.nn.sigmoid(a_gret) * y_ret + jax.nn.sigmoid(a_gmla) * y_mla
    return merged @ w_o


def _swiglu(u, w_gate, w_up, w_down):
    return (jax.nn.silu(u @ w_gate) * (u @ w_up)) @ w_down


def setup_inputs(seed: int = 0) -> dict:
    key = jax.random.key(seed)
    ks = jax.random.split(key, 24)
    f32 = jnp.float32

    def nrm(k, shape, fan_in):
        return jax.random.normal(k, shape, f32) * (fan_in ** -0.5)

    def gain(k, shape):
        return 1.0 + 0.02 * jax.random.normal(k, shape, f32)

    h_idx = jnp.arange(RET_HEADS, dtype=f32)
    gamma = 1.0 - 2.0 ** (-5.0 - h_idx)
    decay_base = jnp.log(-jnp.log(gamma))
    return {
        'x': jax.random.normal(ks[0], (BATCH, SEQ, D_MODEL), f32),
        'meta_tokens': jax.random.normal(ks[1], (N_META, D_MODEL), f32),
        'norm_mix_w': gain(ks[2], (DEPTH, D_MODEL)),
        'w_in': nrm(ks[3], (DEPTH, D_MODEL, D_IN), D_MODEL),
        'ret_decay_fwd': decay_base[None] + 0.05 * jax.random.normal(ks[4], (DEPTH, RET_HEADS), f32),
        'ret_decay_bwd': decay_base[None] + 0.05 * jax.random.normal(ks[5], (DEPTH, RET_HEADS), f32),
        'ret_gn_w': gain(ks[6], (DEPTH, RET_V_W)),
        'w_ret_out': nrm(ks[7], (DEPTH, RET_V_W, D_MODEL), RET_V_W),
        'mla_q_norm_w': gain(ks[8], (DEPTH, MLA_Q_RANK)),
        'w_uq': nrm(ks[9], (DEPTH, MLA_Q_RANK, MLA_HEADS * MLA_QK), MLA_Q_RANK),
        'mla_kv_norm_w': gain(ks[10], (DEPTH, MLA_KV_RANK)),
        'w_uk': nrm(ks[11], (DEPTH, MLA_KV_RANK, MLA_HEADS * MLA_NOPE), MLA_KV_RANK),
        'w_uv': nrm(ks[12], (DEPTH, MLA_KV_RANK, MLA_HEADS * MLA_DV), MLA_KV_RANK),
        'w_mla_out': nrm(ks[13], (DEPTH, MLA_HEADS * MLA_DV, D_MODEL), MLA_HEADS * MLA_DV),
        'w_o': nrm(ks[14], (DEPTH, D_MODEL, D_MODEL), D_MODEL),
        'norm_ffn_w': gain(ks[15], (DEPTH, D_MODEL)),
        'w_ffn_gate': nrm(ks[16], (DEPTH, D_MODEL, D_FF), D_MODEL),
        'w_ffn_up': nrm(ks[17], (DEPTH, D_MODEL, D_FF), D_MODEL),
        'w_ffn_down': nrm(ks[18], (DEPTH, D_FF, D_MODEL), D_FF),
        'norm_final_w': gain(ks[19], (D_MODEL,)),
    }


def reference(x, meta_tokens, norm_mix_w, w_in, ret_decay_fwd, ret_decay_bwd, ret_gn_w, w_ret_out,
              mla_q_norm_w, w_uq, mla_kv_norm_w, w_uk, w_uv, w_mla_out, w_o, norm_ffn_w,
              w_ffn_gate, w_ffn_up, w_ffn_down, norm_final_w):
    B, S, D = x.shape
    L = S + N_META
    meta = jnp.broadcast_to(meta_tokens.astype(x.dtype)[None], (B, N_META, D))
    h = jnp.concatenate([meta, x], axis=1)
    pos = jnp.arange(L)
    ret_cos, ret_sin = _rope_tables(pos, RET_DK)
    mla_cos, mla_sin = _rope_tables(pos, MLA_ROPE)
    for l in range(DEPTH):
        h = h + _mixer(_rmsnorm(h, norm_mix_w[l]), w_in[l], ret_decay_fwd[l], ret_decay_bwd[l], ret_gn_w[l],
                       w_ret_out[l], mla_q_norm_w[l], w_uq[l], mla_kv_norm_w[l], w_uk[l], w_uv[l],
                       w_mla_out[l], w_o[l], ret_cos, ret_sin, mla_cos, mla_sin)
        h = h + _swiglu(_rmsnorm(h, norm_ffn_w[l]), w_ffn_gate[l], w_ffn_up[l], w_ffn_down[l])
    h = _rmsnorm(h, norm_final_w)
    return h[:, N_META:]
```

```cpp
#include <hip/hip_runtime.h>
#include <hip/hip_cooperative_groups.h>
#include <stdint.h>
#include <cstdio>
namespace cg = cooperative_groups;

#ifndef MULTI_LAUNCH
#define MULTI_LAUNCH 1
#endif

typedef unsigned short u16;
typedef __attribute__((ext_vector_type(8))) short bf16x8;
typedef __attribute__((ext_vector_type(16))) float f32x16;
typedef __attribute__((ext_vector_type(4))) unsigned u32x4;
typedef __attribute__((ext_vector_type(2))) unsigned u32x2;
typedef __attribute__((ext_vector_type(2))) float f32x2;
typedef __attribute__((ext_vector_type(2))) __bf16 bf16x2v;

#define DI __device__ __forceinline__
#define MFMA32(a, b, c) __builtin_amdgcn_mfma_f32_32x32x16_bf16((a), (b), (c), 0, 0, 0)

constexpr int M = 32768;
constexpr int MT = 32896;
constexpr int SEQ = 8192;
constexpr int NPOS = 8208;
constexpr int NKEY = 8256;
constexpr int DFF = 2816;
constexpr int NIN = 5888;

constexpr size_t SZ_WIN = (size_t)NIN * 1024 * 2;
constexpr size_t OFF_WIN = 0;
constexpr size_t OFF_WRET = OFF_WIN + SZ_WIN;
constexpr size_t OFF_WUQ = OFF_WRET + 1024 * 1024 * 2;
constexpr size_t OFF_WUKV = OFF_WUQ + 768 * 384 * 2;
constexpr size_t OFF_WMLA = OFF_WUKV + 1024 * 256 * 2;
constexpr size_t OFF_WO = OFF_WMLA + 1024 * 512 * 2;
constexpr size_t OFF_WGU = OFF_WO + 1024 * 1024 * 2;
constexpr size_t OFF_WD = OFF_WGU + (size_t)5632 * 1024 * 2;
constexpr size_t OFF_TRET = OFF_WD + (size_t)1024 * DFF * 2;
constexpr size_t OFF_TMLA = OFF_TRET + (size_t)NPOS * 32 * 8;
constexpr size_t OFF_R1 = OFF_TMLA + (size_t)NPOS * 16 * 8;
constexpr size_t SZ_U = (size_t)MT * 1024 * 2;
constexpr size_t OFF_RQ = OFF_R1 + SZ_U;
constexpr size_t OFF_RK = OFF_RQ + (size_t)M * 512 * 2;
constexpr size_t OFF_RKT = OFF_RK + (size_t)M * 512 * 2;
constexpr size_t OFF_RVT = OFF_RKT + (size_t)512 * MT * 2;
constexpr size_t OFF_RG = OFF_RVT + (size_t)1024 * MT * 2;
constexpr size_t OFF_CQ = OFF_RG + (size_t)M * 1024 * 2;
constexpr size_t OFF_CKV = OFF_CQ + (size_t)MT * 384 * 2;
constexpr size_t OFF_KR = OFF_CKV + (size_t)MT * 256 * 2;
constexpr size_t OFF_SSQ = OFF_KR + (size_t)MT * 32 * 2;
constexpr size_t OFF_SSKV = OFF_SSQ + (size_t)MT * 4 * 4;
constexpr size_t OFF_GRET = OFF_SSKV + (size_t)MT * 4 * 4;
constexpr size_t OFF_GMLA = OFF_GRET + (size_t)M * 1024 * 2;
constexpr size_t WS_END = OFF_GMLA + (size_t)M * 1024 * 2;
constexpr size_t OFF_INCR = OFF_R1;
constexpr size_t OFF_Q = OFF_R1;
constexpr size_t OFF_K = OFF_Q + (size_t)M * 768 * 2;
constexpr size_t OFF_VT = OFF_K + (size_t)32 * NKEY * 96 * 2;
constexpr size_t OFF_AO = OFF_VT + (size_t)32 * 64 * NKEY * 2;
constexpr size_t OFF_MG = OFF_R1;
constexpr size_t OFF_H1B = OFF_RG;
constexpr size_t OFF_SS1 = OFF_CQ;
constexpr size_t OFF_ACT = OFF_R1;
static_assert(OFF_AO + (size_t)M * 512 * 2 <= OFF_RG, "alias overflow");
static_assert(OFF_ACT + (size_t)M * DFF * 2 <= OFF_RG, "alias overflow");

struct Params {
  const float *x, *meta, *norm_mix_w, *w_in, *decay_f, *decay_b, *gn_w, *w_ret_out, *q_norm_w, *w_uq,
      *kv_norm_w, *w_uk, *w_uv, *w_mla_out, *w_o, *norm_ffn_w, *w_gate, *w_up, *w_down, *norm_final_w;
  float* out;
  char* ws;
};

DI unsigned pack2(float a, float b) {
  f32x2 v = {a, b};
  return __builtin_bit_cast(unsigned, __builtin_convertvector(v, bf16x2v));
}
DI u16 f2bf(float a) { return (u16)(pack2(a, 0.f) & 0xffffu); }
DI float bflo(unsigned u) { return __uint_as_float(u << 16); }
DI float bfhi(unsigned u) { return __uint_as_float(u & 0xffff0000u); }
DI float bf2f(u16 v) { return __uint_as_float(((unsigned)v) << 16); }
DI int crow(int i, int hh) { return (i & 3) + 8 * (i >> 2) + 4 * hh; }
DI float sigmoidf_(float x) { return 1.f / (1.f + __expf(-x)); }
DI float siluf_(float x) { return x / (1.f + __expf(-x)); }
DI float wave_sum(float v) {
#pragma unroll
  for (int o = 32; o > 0; o >>= 1) v += __shfl_xor(v, o);
  return v;
}
DI int row_pos(int row) {
  int p = row < M ? (row & (SEQ - 1)) + 16 : row - M;
  return p < NPOS ? p : NPOS - 1;
}
DI void zero_acc(f32x16& a) {
#pragma unroll
  for (int i = 0; i < 16; ++i) a[i] = 0.f;
}

template <int NI>
DI void gemm_core(const u16* __restrict__ A, int lda, const u16* __restrict__ Bt, int ldb, int K,
                  f32x16 (&acc)[2][NI], char* smem) {
  constexpr int BP = 2 * NI;
  char* sA = smem;
  char* sB = smem + 128 * 128;
  const int tid = threadIdx.x, lane = tid & 63, wave = tid >> 6;
  const int wm = wave >> 1, wn = wave & 1;
  const int r = lane & 31, hh = lane >> 5;
  const int lrow = tid >> 3, lc = tid & 7;
  const int wsw = ((lrow >> 1) & 7);
  const int rsw = ((r >> 1) & 7);
  u32x4 ra[4], rb[BP];
  const u16* Ap = A + (size_t)lrow * lda + lc * 8;
  const u16* Bp = Bt + (size_t)lrow * ldb + lc * 8;
#pragma unroll
  for (int p = 0; p < 4; ++p) ra[p] = *(const u32x4*)(Ap + (size_t)(32 * p) * lda);
#pragma unroll
  for (int p = 0; p < BP; ++p) rb[p] = *(const u32x4*)(Bp + (size_t)(32 * p) * ldb);
  const int nk = K >> 6;
  for (int kt = 0; kt < nk; ++kt) {
#pragma unroll
    for (int p = 0; p < 4; ++p) *(u32x4*)(sA + (lrow + 32 * p) * 128 + ((lc ^ wsw) << 4)) = ra[p];
#pragma unroll
    for (int p = 0; p < BP; ++p) *(u32x4*)(sB + (lrow + 32 * p) * 128 + ((lc ^ wsw) << 4)) = rb[p];
    __syncthreads();
    if (kt + 1 < nk) {
      const int ko = (kt + 1) * 64;
#pragma unroll
      for (int p = 0; p < 4; ++p) ra[p] = *(const u32x4*)(Ap + (size_t)(32 * p) * lda + ko);
#pragma unroll
      for (int p = 0; p < BP; ++p) rb[p] = *(const u32x4*)(Bp + (size_t)(32 * p) * ldb + ko);
    }
#pragma unroll
    for (int s = 0; s < 4; ++s) {
      bf16x8 a[2], b[NI];
      const int co = (((2 * s + hh) ^ rsw) << 4);
#pragma unroll
      for (int mi = 0; mi < 2; ++mi) a[mi] = *(const bf16x8*)(sA + (wm * 64 + mi * 32 + r) * 128 + co);
#pragma unroll
      for (int ni = 0; ni < NI; ++ni) b[ni] = *(const bf16x8*)(sB + (wn * 32 * NI + ni * 32 + r) * 128 + co);
#pragma unroll
      for (int mi = 0; mi < 2; ++mi)
#pragma unroll
        for (int ni = 0; ni < NI; ++ni) acc[mi][ni] = MFMA32(a[mi], b[ni], acc[mi][ni]);
    }
    __syncthreads();
  }
}

template <int NI>
DI void rowss_partial(f32x16 (&acc)[2][NI], char* smem, float* ss, int stride, int slab, int row0, bool doit) {
  const int tid = threadIdx.x, lane = tid & 63, wave = tid >> 6;
  const int r = lane & 31, hh = lane >> 5;
  float* sw = (float*)smem + wave * (64 * 33);
#pragma unroll
  for (int mi = 0; mi < 2; ++mi)
#pragma unroll
    for (int i = 0; i < 16; ++i) {
      float t = 0.f;
#pragma unroll
      for (int ni = 0; ni < NI; ++ni) t += acc[mi][ni][i] * acc[mi][ni][i];
      sw[(mi * 32 + crow(i, hh)) * 33 + r] = t;
    }
  __syncthreads();
  float t = 0.f;
#pragma unroll
  for (int j = 0; j < 32; ++j) t += sw[lane * 33 + j];
  if (doit) ss[(size_t)(row0 + (wave >> 1) * 64 + lane) * stride + slab] = t;
  __syncthreads();
}

DI void phase_prep(const Params& p) {
  char* ws = p.ws;
  const int gtid = blockIdx.x * 256 + threadIdx.x, gthreads = gridDim.x * 256;
  const int lane = threadIdx.x & 63;
  const int gwave = gtid >> 6, nwaves = gthreads >> 6;
  u16* U = (u16*)(ws + OFF_R1);
  for (int row = gwave; row < MT; row += nwaves) {
    u32x4 o0 = {0, 0, 0, 0}, o1 = {0, 0, 0, 0};
    if (row < M + 16) {
      const float* src = row < M ? p.x + (size_t)row * 1024 : p.meta + (size_t)(row - M) * 1024;
      float4 v[4];
      v[0] = *(const float4*)(src + lane * 8);
      v[1] = *(const float4*)(src + lane * 8 + 4);
      v[2] = *(const float4*)(src + 512 + lane * 8);
      v[3] = *(const float4*)(src + 512 + lane * 8 + 4);
      float ss = 0.f;
#pragma unroll
      for (int q = 0; q < 4; ++q) ss += v[q].x * v[q].x + v[q].y * v[q].y + v[q].z * v[q].z + v[q].w * v[q].w;
      ss = wave_sum(ss);
      const float rs = rsqrtf(ss * (1.f / 1024.f) + 1e-6f);
      float4 w[4];
      w[0] = *(const float4*)(p.norm_mix_w + lane * 8);
      w[1] = *(const float4*)(p.norm_mix_w + lane * 8 + 4);
      w[2] = *(const float4*)(p.norm_mix_w + 512 + lane * 8);
      w[3] = *(const float4*)(p.norm_mix_w + 512 + lane * 8 + 4);
      o0[0] = pack2(v[0].x * rs * w[0].x, v[0].y * rs * w[0].y);
      o0[1] = pack2(v[0].z * rs * w[0].z, v[0].w * rs * w[0].w);
      o0[2] = pack2(v[1].x * rs * w[1].x, v[1].y * rs * w[1].y);
      o0[3] = pack2(v[1].z * rs * w[1].z, v[1].w * rs * w[1].w);
      o1[0] = pack2(v[2].x * rs * w[2].x, v[2].y * rs * w[2].y);
      o1[1] = pack2(v[2].z * rs * w[2].z, v[2].w * rs * w[2].w);
      o1[2] = pack2(v[3].x * rs * w[3].x, v[3].y * rs * w[3].y);
      o1[3] = pack2(v[3].z * rs * w[3].z, v[3].w * rs * w[3].w);
    }
    *(u32x4*)(U + (size_t)row * 1024 + lane * 8) = o0;
    *(u32x4*)(U + (size_t)row * 1024 + 512 + lane * 8) = o1;
  }
  {
    float2* tr = (float2*)(ws + OFF_TRET);
    for (int idx = gtid; idx < NPOS * 32; idx += gthreads) {
      const int pos = idx >> 5, i = idx & 31;
      const float inv = (float)pow(10000.0, -(double)i / 32.0);
      const float ang = (float)pos * inv;
      tr[idx] = make_float2((float)cos((double)ang), (float)sin((double)ang));
    }
    float2* tm = (float2*)(ws + OFF_TMLA);
    for (int idx = gtid; idx < NPOS * 16; idx += gthreads) {
      const int pos = idx >> 4, i = idx & 15;
      const float inv = (float)pow(10000.0, -(double)i / 16.0);
      const float ang = (float)pos * inv;
      tm[idx] = make_float2((float)cos((double)ang), (float)sin((double)ang));
    }
  }
  for (int job = 0; job < 8; ++job) {
    int N, K;
    u16* dst;
    switch (job) {
      case 0: N = NIN; K = 1024; dst = (u16*)(ws + OFF_WIN); break;
      case 1: N = 1024; K = 1024; dst = (u16*)(ws + OFF_WRET); break;
      case 2: N = 768; K = 384; dst = (u16*)(ws + OFF_WUQ); break;
      case 3: N = 1024; K = 256; dst = (u16*)(ws + OFF_WUKV); break;
      case 4: N = 1024; K = 512; dst = (u16*)(ws + OFF_WMLA); break;
      case 5: N = 1024; K = 1024; dst = (u16*)(ws + OFF_WO); break;
      case 6: N = 5632; K = 1024; dst = (u16*)(ws + OFF_WGU); break;
      default: N = 1024; K = DFF; dst = (u16*)(ws + OFF_WD); break;
    }
    const int total = N * (K >> 3);
    for (int idx = gtid; idx < total; idx += gthreads) {
      const int kc = idx / N, n = idx - kc * N;
      const float* src = nullptr;
      int ld = 0;
      const float* scale = nullptr;
      switch (job) {
        case 0: {
          ld = 5792;
          if (n < 3712) src = p.w_in + n;
          else if (n < 5760) src = p.w_in + n + 32;
          else if (n < 5824) {
            const int c = n - 5760;
            if (c < 16) src = p.w_in + 3712 + c;
            else if (c >= 32 && c < 48) src = p.w_in + 3712 + 16 + (c - 32);
          }
        } break;
        case 1: ld = 1024; src = p.w_ret_out + n; scale = p.gn_w; break;
        case 2: {
          ld = 768;
          scale = p.q_norm_w;
          if (n < 512) src = p.w_uq + (n >> 6) * 96 + (n & 63);
          else {
            const int g = (n - 512) >> 6, c = (n - 512) & 63;
            const int half = c >> 5, hsel = (c >> 4) & 1, j = c & 15;
            src = p.w_uq + (2 * g + hsel) * 96 + 64 + half * 16 + j;
          }
        } break;
        case 3: ld = 512; scale = p.kv_norm_w; src = n < 512 ? p.w_uk + n : p.w_uv + (n - 512); break;
        case 4: ld = 1024; src = p.w_mla_out + n; break;
        case 5: ld = 1024; src = p.w_o + n; break;
        case 6: {
          ld = DFF;
          scale = p.norm_ffn_w;
          const int blk = n >> 6, c = n & 63;
          src = c < 32 ? p.w_gate + blk * 32 + c : p.w_up + blk * 32 + (c - 32);
        } break;
        default: ld = 1024; src = p.w_down + n; break;
      }
      float v[8];
#pragma unroll
      for (int j = 0; j < 8; ++j) {
        const int k = kc * 8 + j;
        float t = src ? src[(size_t)k * ld] : 0.f;
        if (scale) t *= scale[k];
        v[j] = t;
      }
      u32x4 o;
      o[0] = pack2(v[0], v[1]); o[1] = pack2(v[2], v[3]); o[2] = pack2(v[4], v[5]); o[3] = pack2(v[6], v[7]);
      *(u32x4*)(dst + (size_t)n * K + kc * 8) = o;
    }
  }
}

DI void phase_proj(const Params& p, char* smem) {
  char* ws = p.ws;
  const u16* U = (const u16*)(ws + OFF_R1);
  const u16* W = (const u16*)(ws + OFF_WIN);
  u16* RQ = (u16*)(ws + OFF_RQ);
  u16* RK = (u16*)(ws + OFF_RK);
  u16* RKT = (u16*)(ws + OFF_RKT);
  u16* RVT = (u16*)(ws + OFF_RVT);
  u16* RG = (u16*)(ws + OFF_RG);
  u16* CQ = (u16*)(ws + OFF_CQ);
  u16* CKV = (u16*)(ws + OFF_CKV);
  u16* KR = (u16*)(ws + OFF_KR);
  u16* GRET = (u16*)(ws + OFF_GRET);
  u16* GMLA = (u16*)(ws + OFF_GMLA);
  float* SSQ = (float*)(ws + OFF_SSQ);
  float* SSKV = (float*)(ws + OFF_SSKV);
  const float2* TR = (const float2*)(ws + OFF_TRET);
  const float2* TM = (const float2*)(ws + OFF_TMLA);
  const int tid = threadIdx.x, lane = tid & 63, wave = tid >> 6;
  const int wm = wave >> 1, wn = wave & 1, r = lane & 31, hh = lane >> 5;
  constexpr int NT = NIN / 256;
  const int ntiles = (MT / 128) * NT;
  for (int t = blockIdx.x; t < ntiles; t += gridDim.x) {
    const int mt = t / NT, nt = t - mt * NT;
    const int m0 = mt * 128, n0 = nt * 256;
    f32x16 acc[2][4];
#pragma unroll
    for (int mi = 0; mi < 2; ++mi)
#pragma unroll
      for (int ni = 0; ni < 4; ++ni) zero_acc(acc[mi][ni]);
    gemm_core<4>(U + (size_t)m0 * 1024, 1024, W + (size_t)n0 * 1024, 1024, 1024, acc, smem);
    const int col0 = n0 + wn * 128;
    const int rowb = m0 + wm * 64;
    if (n0 >= 3072 && n0 < 3712) {
      const bool isq = col0 < 3456;
      const bool iskv = col0 >= 3456 && col0 < 3712;
      rowss_partial<4>(acc, smem, isq ? SSQ : SSKV, 4, isq ? (col0 - 3072) >> 7 : (col0 - 3456) >> 7, m0, isq || iskv);
    }
    if (col0 < 1024) {
      const bool isk = col0 >= 512;
#pragma unroll
      for (int mi = 0; mi < 2; ++mi)
#pragma unroll
        for (int g4 = 0; g4 < 4; ++g4) {
          float o1[2][4], o2[2][4];
#pragma unroll
          for (int ii = 0; ii < 4; ++ii) {
            const int i = g4 * 4 + ii;
            const int row = rowb + mi * 32 + crow(i, hh);
            const float2 cs = TR[row_pos(row) * 32 + r];
#pragma unroll
            for (int gi = 0; gi < 2; ++gi) {
              float x1 = acc[mi][2 * gi][i], x2 = acc[mi][2 * gi + 1][i];
              float a = x1 * cs.x - x2 * cs.y, b = x1 * cs.y + x2 * cs.x;
              if (isk) { a *= 0.125f; b *= 0.125f; }
              o1[gi][ii] = a; o2[gi][ii] = b;
            }
          }
          const int rowq = rowb + mi * 32 + 8 * g4 + 4 * hh;
#pragma unroll
          for (int gi = 0; gi < 2; ++gi) {
            const int hc = (col0 & 511) + gi * 64;
            if (rowq < M) {
              u16* dst = (isk ? RK : RQ) + (size_t)rowq * 512 + hc + r;
#pragma unroll
              for (int ii = 0; ii < 4; ++ii) {
                dst[(size_t)ii * 512] = f2bf(o1[gi][ii]);
                dst[(size_t)ii * 512 + 32] = f2bf(o2[gi][ii]);
              }
            }
            if (isk) {
              u32x2 q1 = {pack2(o1[gi][0], o1[gi][1]), pack2(o1[gi][2], o1[gi][3])};
              u32x2 q2 = {pack2(o2[gi][0], o2[gi][1]), pack2(o2[gi][2], o2[gi][3])};
              *(u32x2*)(RKT + (size_t)(hc + r) * MT + rowq) = q1;
              *(u32x2*)(RKT + (size_t)(hc + 32 + r) * MT + rowq) = q2;
            }
          }
        }
    } else if (col0 < 2048) {
#pragma unroll
      for (int mi = 0; mi < 2; ++mi)
#pragma unroll
        for (int g4 = 0; g4 < 4; ++g4) {
          const int rowq = rowb + mi * 32 + 8 * g4 + 4 * hh;
#pragma unroll
          for (int ni = 0; ni < 4; ++ni) {
            const int c = col0 - 1024 + ni * 32 + r;
            u32x2 q = {pack2(acc[mi][ni][4 * g4], acc[mi][ni][4 * g4 + 1]), pack2(acc[mi][ni][4 * g4 + 2], acc[mi][ni][4 * g4 + 3])};
            *(u32x2*)(RVT + (size_t)c * MT + rowq) = q;
          }
        }
    } else if (col0 < 3072 || (col0 >= 3712 && col0 < 5760)) {
      const bool issilu = col0 < 3072;
      u16* dstb = issilu ? RG + (col0 - 2048) : (col0 < 4736 ? GRET + (col0 - 3712) : GMLA + (col0 - 4736));
#pragma unroll
      for (int mi = 0; mi < 2; ++mi)
#pragma unroll
        for (int i = 0; i < 16; ++i) {
          const int row = rowb + mi * 32 + crow(i, hh);
          if (row < M) {
#pragma unroll
            for (int ni = 0; ni < 4; ++ni) {
              const float v = acc[mi][ni][i];
              dstb[(size_t)row * 1024 + ni * 32 + r] = f2bf(issilu ? siluf_(v) : sigmoidf_(v));
            }
          }
        }
    } else if (col0 < 3712) {
      const bool isq = col0 < 3456;
      u16* dstb = isq ? CQ + (col0 - 3072) : CKV + (col0 - 3456);
      const int ld = isq ? 384 : 256;
#pragma unroll
      for (int mi = 0; mi < 2; ++mi)
#pragma unroll
        for (int i = 0; i < 16; ++i) {
          const int row = rowb + mi * 32 + crow(i, hh);
#pragma unroll
          for (int ni = 0; ni < 4; ++ni) dstb[(size_t)row * ld + ni * 32 + r] = f2bf(acc[mi][ni][i]);
        }
    } else if (col0 == 5760) {
      if (r < 16) {
#pragma unroll
        for (int mi = 0; mi < 2; ++mi)
#pragma unroll
          for (int i = 0; i < 16; ++i) {
            const int row = rowb + mi * 32 + crow(i, hh);
            const float2 cs = TM[row_pos(row) * 16 + r];
            const float x1 = acc[mi][0][i], x2 = acc[mi][1][i];
            KR[(size_t)row * 32 + r] = f2bf(x1 * cs.x - x2 * cs.y);
            KR[(size_t)row * 32 + 16 + r] = f2bf(x1 * cs.y + x2 * cs.x);
          }
      }
    }
  }
}

DI void phase_ret_incr(const Params& p, char* smem) {
  char* ws = p.ws;
  const u16* RKT = (const u16*)(ws + OFF_RKT);
  const u16* RVT = (const u16*)(ws + OFF_RVT);
  u16* INCR = (u16*)(ws + OFF_INCR);
  char* sV = smem;
  char* sK = smem + 32768;
  float* sW = (float*)(smem + 49152);
  const int tid = threadIdx.x, lane = tid & 63, wave = tid >> 6;
  const int r = lane & 31, hh = lane >> 5;
  const float LOG2E = 1.4426950408889634f;
  for (int item = blockIdx.x; item < 4 * 65 * 8; item += gridDim.x) {
    const int h = item & 7, c = (item >> 3) % 65, b = item / (8 * 65);
    const int col0 = c < 64 ? b * SEQ + c * 128 : M;
    const float lgf2 = -__expf(p.decay_f[h]) * LOG2E, lgb2 = -__expf(p.decay_b[h]) * LOG2E;
    __syncthreads();
    if (tid < 128) {
      sW[tid] = exp2f(lgf2 * (float)((c < 64 ? 127 : 15) - tid));
      sW[128 + tid] = exp2f(lgb2 * (float)tid);
    }
    {
      const int lr = tid >> 4, lc = tid & 15;
#pragma unroll
      for (int q = 0; q < 8; ++q) {
        const int row = lr + 16 * q;
        u32x4 v = *(const u32x4*)(RVT + (size_t)(h * 128 + row) * MT + col0 + lc * 8);
        *(u32x4*)(sV + row * 256 + ((lc ^ (row & 15)) << 4)) = v;
      }
#pragma unroll
      for (int q = 0; q < 4; ++q) {
        const int row = lr + 16 * q;
        u32x4 v = *(const u32x4*)(RKT + (size_t)(h * 64 + row) * MT + col0 + lc * 8);
        *(u32x4*)(sK + row * 256 + ((lc ^ (row & 15)) << 4)) = v;
      }
    }
    __syncthreads();
    f32x16 af[2], ab[2];
    zero_acc(af[0]); zero_acc(af[1]); zero_acc(ab[0]); zero_acc(ab[1]);
#pragma unroll
    for (int s = 0; s < 8; ++s) {
      const int ch = 2 * s + hh;
      const int e = wave * 32 + r;
      const bf16x8 a = *(const bf16x8*)(sV + e * 256 + ((ch ^ (e & 15)) << 4));
      const float4 wf0 = *(const float4*)(sW + ch * 8), wf1 = *(const float4*)(sW + ch * 8 + 4);
      const float4 wb0 = *(const float4*)(sW + 128 + ch * 8), wb1 = *(const float4*)(sW + 128 + ch * 8 + 4);
#pragma unroll
      for (int nb = 0; nb < 2; ++nb) {
        const int d = nb * 32 + r;
        const u32x4 kv = *(const u32x4*)(sK + d * 256 + ((ch ^ (d & 15)) << 4));
        u32x4 kf, kb;
        kf[0] = pack2(bflo(kv[0]) * wf0.x, bfhi(kv[0]) * wf0.y);
        kf[1] = pack2(bflo(kv[1]) * wf0.z, bfhi(kv[1]) * wf0.w);
        kf[2] = pack2(bflo(kv[2]) * wf1.x, bfhi(kv[2]) * wf1.y);
        kf[3] = pack2(bflo(kv[3]) * wf1.z, bfhi(kv[3]) * wf1.w);
        kb[0] = pack2(bflo(kv[0]) * wb0.x, bfhi(kv[0]) * wb0.y);
        kb[1] = pack2(bflo(kv[1]) * wb0.z, bfhi(kv[1]) * wb0.w);
        kb[2] = pack2(bflo(kv[2]) * wb1.x, bfhi(kv[2]) * wb1.y);
        kb[3] = pack2(bflo(kv[3]) * wb1.z, bfhi(kv[3]) * wb1.w);
        af[nb] = MFMA32(a, __builtin_bit_cast(bf16x8, kf), af[nb]);
        ab[nb] = MFMA32(a, __builtin_bit_cast(bf16x8, kb), ab[nb]);
      }
    }
    const int fslot = c == 64 ? 0 : (c <= 62 ? c + 1 : -1);
    const int bslot = (c >= 1 && c < 64) ? c - 1 : -1;
#pragma unroll
    for (int nb = 0; nb < 2; ++nb)
#pragma unroll
      for (int i = 0; i < 16; ++i) {
        const int e = wave * 32 + crow(i, hh), d = nb * 32 + r;
        if (fslot >= 0) INCR[((size_t)((0 * 4 + b) * 64 + fslot) * 8 + h) * 8192 + e * 64 + d] = f2bf(af[nb][i]);
        if (bslot >= 0) INCR[((size_t)((1 * 4 + b) * 64 + bslot) * 8 + h) * 8192 + e * 64 + d] = f2bf(ab[nb][i]);
      }
  }
}

DI void phase_ret_scan(const Params& p) {
  unsigned* INCR = (unsigned*)(p.ws + OFF_INCR);
  const int gtid = blockIdx.x * 256 + threadIdx.x, gthreads = gridDim.x * 256;
  const float LOG2E = 1.4426950408889634f;
  for (int idx = gtid; idx < 2 * 4 * 8 * 4096; idx += gthreads) {
    const int pr = idx & 4095, h = (idx >> 12) & 7, b = (idx >> 15) & 3, dir = idx >> 17;
    const float lg2 = -__expf(dir ? p.decay_b[h] : p.decay_f[h]) * LOG2E;
    const float g = exp2f(lg2 * 128.f);
    unsigned* base = INCR + (size_t)(dir * 4 + b) * 64 * 8 * 4096 + (size_t)h * 4096 + pr;
    float s0 = 0.f, s1 = 0.f;
    if (dir == 0) {
      for (int n = 0; n < 64; ++n) {
        unsigned* q = base + (size_t)n * 8 * 4096;
        const unsigned u = *q;
        s0 = g * s0 + bflo(u); s1 = g * s1 + bfhi(u);
        *q = pack2(s0, s1);
      }
    } else {
      base[(size_t)63 * 8 * 4096] = 0u;
      for (int n = 62; n >= 0; --n) {
        unsigned* q = base + (size_t)n * 8 * 4096;
        const unsigned u = *q;
        s0 = g * s0 + bflo(u); s1 = g * s1 + bfhi(u);
        *q = pack2(s0, s1);
      }
    }
  }
}

DI void phase_ret_out(const Params& p, char* smem) {
  char* ws = p.ws;
  const u16* RQ = (const u16*)(ws + OFF_RQ);
  const u16* RK = (const u16*)(ws + OFF_RK);
  const u16* RVT = (const u16*)(ws + OFF_RVT);
  const u16* ST = (const u16*)(ws + OFF_INCR);
  u16* RG = (u16*)(ws + OFF_RG);
  const int tid = threadIdx.x, lane = tid & 63, wave = tid >> 6;
  const int r = lane & 31, hh = lane >> 5;
  const float LOG2E = 1.4426950408889634f;
  for (int item = blockIdx.x; item < 4 * 64 * 8; item += gridDim.x) {
    const int h = item & 7, n = (item >> 3) & 63, b = item >> 9;
    const int row0 = b * SEQ + n * 128;
    const float lgf2 = -__expf(p.decay_f[h]) * LOG2E, lgb2 = -__expf(p.decay_b[h]) * LOG2E;
    const int qi = wave * 32 + r;
    bf16x8 qf[4];
#pragma unroll
    for (int s = 0; s < 4; ++s) qf[s] = *(const bf16x8*)(RQ + (size_t)(row0 + qi) * 512 + h * 64 + (2 * s + hh) * 8);
    __syncthreads();
    char* sF = smem;
    char* sB = smem + 16384;
    {
      const int lr = tid >> 3, lc = tid & 7;
      const u16* gf = ST + ((size_t)((0 * 4 + b) * 64 + n) * 8 + h) * 8192;
      const u16* gb = ST + ((size_t)((1 * 4 + b) * 64 + n) * 8 + h) * 8192;
#pragma unroll
      for (int q = 0; q < 4; ++q) {
        const int row = lr + 32 * q;
        const int so = row * 128 + ((lc ^ ((row >> 1) & 7)) << 4);
        *(u32x4*)(sF + so) = *(const u32x4*)(gf + row * 64 + lc * 8);
        *(u32x4*)(sB + so) = *(const u32x4*)(gb + row * 64 + lc * 8);
      }
    }
    __syncthreads();
    f32x16 O[4];
    {
      const float wq = __builtin_amdgcn_exp2f(lgf2 * (float)(qi + 1));
      const float wqb = __builtin_amdgcn_exp2f(lgb2 * (float)(128 - qi));
#pragma unroll
      for (int eb = 0; eb < 4; ++eb) {
        const int e = eb * 32 + r;
        f32x16 t;
        zero_acc(t);
#pragma unroll
        for (int s = 0; s < 4; ++s) {
          const bf16x8 a = *(const bf16x8*)(sF + e * 128 + (((2 * s + hh) ^ ((e >> 1) & 7)) << 4));
          t = MFMA32(a, qf[s], t);
        }
#pragma unroll
        for (int i = 0; i < 16; ++i) O[eb][i] = t[i] * wq;
        zero_acc(t);
#pragma unroll
        for (int s = 0; s < 4; ++s) {
          const bf16x8 a = *(const bf16x8*)(sB + e * 128 + (((2 * s + hh) ^ ((e >> 1) & 7)) << 4));
          t = MFMA32(a, qf[s], t);
        }
#pragma unroll
        for (int i = 0; i < 16; ++i) O[eb][i] += t[i] * wqb;
      }
    }
    __syncthreads();
    char* sK = smem;
    char* sV = smem + 16384;
    {
      const int lr = tid >> 3, lc = tid & 7;
#pragma unroll
      for (int q = 0; q < 4; ++q) {
        const int row = lr + 32 * q;
        *(u32x4*)(sK + row * 128 + ((lc ^ ((row >> 1) & 7)) << 4)) = *(const u32x4*)(RK + (size_t)(row0 + row) * 512 + h * 64 + lc * 8);
      }
      const int vr = tid >> 4, vc = tid & 15;
#pragma unroll
      for (int q = 0; q < 8; ++q) {
        const int row = vr + 16 * q;
        *(u32x4*)(sV + row * 256 + ((vc ^ (row & 15)) << 4)) = *(const u32x4*)(RVT + (size_t)(h * 128 + row) * MT + row0 + vc * 8);
      }
    }
    __syncthreads();
    const int r_sw = (r & 0x13) | ((r & 4) << 1) | ((r & 8) >> 1);
#pragma unroll 1
    for (int kb = 0; kb < 4; ++kb) {
      f32x16 S;
      zero_acc(S);
      const int krow = kb * 32 + r_sw;
#pragma unroll
      for (int s = 0; s < 4; ++s) {
        const bf16x8 a = *(const bf16x8*)(sK + krow * 128 + (((2 * s + hh) ^ ((krow >> 1) & 7)) << 4));
        S = MFMA32(a, qf[s], S);
      }
      u32x4 pf[2];
#pragma unroll
      for (int t = 0; t < 2; ++t) {
        float pv[8];
#pragma unroll
        for (int jj = 0; jj < 8; ++jj) {
          const int key = kb * 32 + 16 * t + 8 * hh + jj;
          const int dlt = qi - key;
          const float w = __builtin_amdgcn_exp2f(dlt >= 0 ? lgf2 * (float)dlt : lgb2 * (float)(-dlt));
          pv[jj] = S[8 * t + jj] * w;
        }
        pf[t][0] = pack2(pv[0], pv[1]); pf[t][1] = pack2(pv[2], pv[3]);
        pf[t][2] = pack2(pv[4], pv[5]); pf[t][3] = pack2(pv[6], pv[7]);
      }
#pragma unroll
      for (int t = 0; t < 2; ++t) {
        const int ch = 2 * (2 * kb + t) + hh;
#pragma unroll
        for (int eb = 0; eb < 4; ++eb) {
          const int e = eb * 32 + r;
          const bf16x8 a = *(const bf16x8*)(sV + e * 256 + ((ch ^ (e & 15)) << 4));
          O[eb] = MFMA32(a, __builtin_bit_cast(bf16x8, pf[t]), O[eb]);
        }
      }
    }
    float sum = 0.f;
#pragma unroll
    for (int eb = 0; eb < 4; ++eb)
#pragma unroll
      for (int i = 0; i < 16; ++i) sum += O[eb][i];
    sum += __shfl_xor(sum, 32);
    const float mu = sum * (1.f / 128.f);
    float var = 0.f;
#pragma unroll
    for (int eb = 0; eb < 4; ++eb)
#pragma unroll
      for (int i = 0; i < 16; ++i) { const float d = O[eb][i] - mu; var += d * d; }
    var += __shfl_xor(var, 32);
    const float rstd = rsqrtf(var * (1.f / 128.f) + 1e-5f);
    u16* grow = RG + (size_t)(row0 + qi) * 1024 + h * 128;
#pragma unroll
    for (int eb = 0; eb < 4; ++eb)
#pragma unroll
      for (int g4 = 0; g4 < 4; ++g4) {
        u32x2* gp = (u32x2*)(grow + eb * 32 + 8 * g4 + 4 * hh);
        const u32x2 gv = *gp;
        const float y0 = (O[eb][4 * g4] - mu) * rstd * bflo(gv[0]);
        const float y1 = (O[eb][4 * g4 + 1] - mu) * rstd * bfhi(gv[0]);
        const float y2 = (O[eb][4 * g4 + 2] - mu) * rstd * bflo(gv[1]);
        const float y3 = (O[eb][4 * g4 + 3] - mu) * rstd * bfhi(gv[1]);
        u32x2 o = {pack2(y0, y1), pack2(y2, y3)};
        *gp = o;
      }
  }
}

DI void phase_mla_proj(const Params& p, char* smem) {
  char* ws = p.ws;
  const u16* KR = (const u16*)(ws + OFF_KR);
  u16* Q = (u16*)(ws + OFF_Q);
  u16* Kb = (u16*)(ws + OFF_K);
  u16* VT = (u16*)(ws + OFF_VT);
  const float2* TM = (const float2*)(ws + OFF_TMLA);
  const int tid = threadIdx.x, lane = tid & 63, wave = tid >> 6;
  const int wm = wave >> 1, wn = wave & 1, r = lane & 31, hh = lane >> 5;
  float* sRS = (float*)(smem + 49152);
  const float QSCALE = 0.10206207261596577f * 1.4426950408889634f;
  const int nq = 256 * 3, nkv = 257 * 4;
  for (int t = blockIdx.x; t < nq + nkv; t += gridDim.x) {
    const bool isq = t < nq;
    const int tt = isq ? t : t - nq;
    const int NT = isq ? 3 : 4;
    const int mt = tt / NT, nt = tt - mt * NT;
    const int m0 = mt * 128, n0 = nt * 256;
    const int K = isq ? 384 : 256;
    __syncthreads();
    if (tid < 128) {
      const float* ss = (const float*)(ws + (isq ? OFF_SSQ : OFF_SSKV)) + (size_t)(m0 + tid) * 4;
      float rs;
      if (isq) rs = rsqrtf((ss[0] + ss[1] + ss[2]) * (1.f / 384.f) + 1e-6f) * QSCALE;
      else rs = rsqrtf((ss[0] + ss[1]) * (1.f / 256.f) + 1e-6f);
      sRS[tid] = rs;
    }
    f32x16 acc[2][4];
#pragma unroll
    for (int mi = 0; mi < 2; ++mi)
#pragma unroll
      for (int ni = 0; ni < 4; ++ni) zero_acc(acc[mi][ni]);
    {
      const u16* Ab = (const u16*)(ws + (isq ? OFF_CQ : OFF_CKV)) + (size_t)m0 * K;
      const u16* Bb = (const u16*)(ws + (isq ? OFF_WUQ : OFF_WUKV)) + (size_t)n0 * K;
      gemm_core<4>(Ab, K, Bb, K, K, acc, smem);
    }
    const int col0 = n0 + wn * 128;
    const int rl0 = wm * 64;
    if (isq) {
      if (col0 < 512) {
#pragma unroll
        for (int mi = 0; mi < 2; ++mi)
#pragma unroll
          for (int i = 0; i < 16; ++i) {
            const int rl = rl0 + mi * 32 + crow(i, hh);
            const float rs = sRS[rl];
            u16* qrow = Q + (size_t)(m0 + rl) * 768 + (col0 >> 6) * 96 + r;
#pragma unroll
            for (int ni = 0; ni < 4; ++ni) qrow[(ni >> 1) * 96 + (ni & 1) * 32] = f2bf(acc[mi][ni][i] * rs);
          }
      } else {
#pragma unroll
        for (int mi = 0; mi < 2; ++mi)
#pragma unroll
          for (int i = 0; i < 16; ++i) {
            const int rl = rl0 + mi * 32 + crow(i, hh);
            const float rs = sRS[rl];
            const float2 cs = TM[row_pos(m0 + rl) * 16 + (r & 15)];
#pragma unroll
            for (int gi = 0; gi < 2; ++gi) {
              const int g = ((col0 - 512) >> 6) + gi;
              const int head = 2 * g + (r >> 4), j = r & 15;
              const float x1 = acc[mi][2 * gi][i] * rs, x2 = acc[mi][2 * gi + 1][i] * rs;
              u16* dst = Q + (size_t)(m0 + rl) * 768 + head * 96 + 64 + j;
              dst[0] = f2bf(x1 * cs.x - x2 * cs.y);
              dst[16] = f2bf(x1 * cs.y + x2 * cs.x);
            }
          }
      }
    } else {
      const bool ismeta = m0 >= M;
      const int nrep = ismeta ? 4 : 1;
      const int key0 = ismeta ? SEQ : (m0 & (SEQ - 1));
      if (!(ismeta && wm)) {
#pragma unroll 1
        for (int rep = 0; rep < nrep; ++rep) {
          const int bb = ismeta ? rep : (m0 >> 13);
          if (col0 < 512) {
            u16* kbase = Kb + ((size_t)(bb * 8 + (col0 >> 6)) * NKEY + key0) * 96 + r;
#pragma unroll
            for (int mi = 0; mi < 2; ++mi)
#pragma unroll
              for (int i = 0; i < 16; ++i) {
                const int rl = rl0 + mi * 32 + crow(i, hh);
                const float rs = sRS[rl];
#pragma unroll
                for (int ni = 0; ni < 4; ++ni)
                  kbase[(size_t)(ni >> 1) * NKEY * 96 + (size_t)rl * 96 + (ni & 1) * 32] = f2bf(acc[mi][ni][i] * rs);
              }
          } else {
            u16* vbase = VT + ((size_t)(bb * 8 + ((col0 - 512) >> 6)) * 64 + r) * NKEY + key0;
#pragma unroll
            for (int mi = 0; mi < 2; ++mi)
#pragma unroll
              for (int g4 = 0; g4 < 4; ++g4) {
                const int rl = rl0 + mi * 32 + 8 * g4 + 4 * hh;
                const float4 rs4 = *(const float4*)(sRS + rl);
#pragma unroll
                for (int ni = 0; ni < 4; ++ni) {
                  u32x2 q = {pack2(acc[mi][ni][4 * g4] * rs4.x, acc[mi][ni][4 * g4 + 1] * rs4.y),
                             pack2(acc[mi][ni][4 * g4 + 2] * rs4.z, acc[mi][ni][4 * g4 + 3] * rs4.w)};
                  *(u32x2*)(vbase + (size_t)(ni >> 1) * 64 * NKEY + (size_t)((ni & 1) * 32) * NKEY + rl) = q;
                }
              }
          }
        }
      }
    }
  }
  {
    const int gtid = blockIdx.x * 256 + tid, gthreads = gridDim.x * 256;
    const int total = (M + 64) * 8 * 4;
    for (int idx = gtid; idx < total; idx += gthreads) {
      const int c = idx & 3, head = (idx >> 2) & 7, row = idx >> 5;
      const u32x4 v = *(const u32x4*)(KR + (size_t)row * 32 + c * 8);
      if (row < M) {
        const int bb = row >> 13, key = row & (SEQ - 1);
        *(u32x4*)(Kb + ((size_t)(bb * 8 + head) * NKEY + key) * 96 + 64 + c * 8) = v;
      } else {
#pragma unroll 1
        for (int bb = 0; bb < 4; ++bb) *(u32x4*)(Kb + ((size_t)(bb * 8 + head) * NKEY + SEQ + (row - M)) * 96 + 64 + c * 8) = v;
      }
    }
  }
}

DI void phase_attn(const Params& p, char* smem) {
  char* ws = p.ws;
  const u16* Q = (const u16*)(ws + OFF_Q);
  const u16* Kb = (const u16*)(ws + OFF_K);
  const u16* VT = (const u16*)(ws + OFF_VT);
  u16* AO = (u16*)(ws + OFF_AO);
  char* sK = smem;
  char* sV = smem + 12288;
  const int tid = threadIdx.x, lane = tid & 63, wave = tid >> 6;
  const int r = lane & 31, hh = lane >> 5;
  const int r_sw = (r & 0x13) | ((r & 4) << 1) | ((r & 8) >> 1);
  constexpr int NTILE = NKEY / 64;
  for (int item = blockIdx.x; item < 32 * 64; item += gridDim.x) {
    const int qb = item & 63, bh = item >> 6;
    const int b = bh >> 3, h = bh & 7;
    const int qrow = b * SEQ + qb * 128 + wave * 32 + r;
    bf16x8 qf[6];
#pragma unroll
    for (int s = 0; s < 6; ++s) qf[s] = *(const bf16x8*)(Q + (size_t)qrow * 768 + h * 96 + (2 * s + hh) * 8);
    const u16* Kg = Kb + (size_t)bh * NKEY * 96;
    const u16* Vg = VT + (size_t)bh * 64 * NKEY;
    f32x16 O[2];
    zero_acc(O[0]); zero_acc(O[1]);
    float mrun = -INFINITY, lrun = 0.f;
    u32x4 pk[3], pv[2];
#pragma unroll
    for (int q = 0; q < 3; ++q) pk[q] = *(const u32x4*)(Kg + (size_t)(tid + 256 * q) * 8);
#pragma unroll
    for (int q = 0; q < 2; ++q) {
      const int ci = tid + 256 * q;
      pv[q] = *(const u32x4*)(Vg + (size_t)(ci >> 3) * NKEY + (ci & 7) * 8);
    }
    for (int kt = 0; kt < NTILE; ++kt) {
      __syncthreads();
#pragma unroll
      for (int q = 0; q < 3; ++q) {
        const int ci = tid + 256 * q;
        const int row = ci / 12, c = ci - row * 12;
        *(u32x4*)(sK + row * 192 + ((c ^ ((row >> 2) & 3)) << 4)) = pk[q];
      }
#pragma unroll
      for (int q = 0; q < 2; ++q) {
        const int ci = tid + 256 * q;
        const int row = ci >> 3, c = ci & 7;
        *(u32x4*)(sV + row * 128 + ((c ^ ((row >> 1) & 7)) << 4)) = pv[q];
      }
      __syncthreads();
      if (kt + 1 < NTILE) {
#pragma unroll
        for (int q = 0; q < 3; ++q) pk[q] = *(const u32x4*)(Kg + (size_t)(kt + 1) * 64 * 96 + (size_t)(tid + 256 * q) * 8);
#pragma unroll
        for (int q = 0; q < 2; ++q) {
          const int ci = tid + 256 * q;
          pv[q] = *(const u32x4*)(Vg + (size_t)(ci >> 3) * NKEY + (kt + 1) * 64 + (ci & 7) * 8);
        }
      }
      f32x16 S[2];
      zero_acc(S[0]); zero_acc(S[1]);
#pragma unroll
      for (int s = 0; s < 6; ++s)
#pragma unroll
        for (int mb = 0; mb < 2; ++mb) {
          const int krow = mb * 32 + r_sw;
          const bf16x8 a = *(const bf16x8*)(sK + krow * 192 + (((2 * s + hh) ^ ((krow >> 2) & 3)) << 4));
          S[mb] = MFMA32(a, qf[s], S[mb]);
        }
      if (kt == NTILE - 1) {
#pragma unroll
        for (int i = 0; i < 16; ++i) {
          if (i >= 8) S[0][i] = -INFINITY;
          S[1][i] = -INFINITY;
        }
      }
      float mx = S[0][0];
#pragma unroll
      for (int i = 1; i < 16; ++i) mx = fmaxf(mx, S[0][i]);
#pragma unroll
      for (int i = 0; i < 16; ++i) mx = fmaxf(mx, S[1][i]);
      mx = fmaxf(mx, __shfl_xor(mx, 32));
      const float mnew = fmaxf(mrun, mx);
      const float alpha = __builtin_amdgcn_exp2f(mrun - mnew);
      mrun = mnew;
      float ls = 0.f;
#pragma unroll
      for (int mb = 0; mb < 2; ++mb)
#pragma unroll
        for (int i = 0; i < 16; ++i) {
          const float e = __builtin_amdgcn_exp2f(S[mb][i] - mnew);
          S[mb][i] = e;
          ls += e;
        }
      lrun = lrun * alpha + ls;
#pragma unroll
      for (int dvb = 0; dvb < 2; ++dvb)
#pragma unroll
        for (int i = 0; i < 16; ++i) O[dvb][i] *= alpha;
#pragma unroll
      for (int sp = 0; sp < 4; ++sp) {
        const int mb = sp >> 1, t = sp & 1;
        u32x4 pf;
        pf[0] = pack2(S[mb][8 * t + 0], S[mb][8 * t + 1]);
        pf[1] = pack2(S[mb][8 * t + 2], S[mb][8 * t + 3]);
        pf[2] = pack2(S[mb][8 * t + 4], S[mb][8 * t + 5]);
        pf[3] = pack2(S[mb][8 * t + 6], S[mb][8 * t + 7]);
#pragma unroll
        for (int dvb = 0; dvb < 2; ++dvb) {
          const int e = dvb * 32 + r;
          const bf16x8 a = *(const bf16x8*)(sV + e * 128 + (((2 * sp + hh) ^ ((e >> 1) & 7)) << 4));
          O[dvb] = MFMA32(a, __builtin_bit_cast(bf16x8, pf), O[dvb]);
        }
      }
    }
    lrun += __shfl_xor(lrun, 32);
    const float inv = 1.f / lrun;
    u16* dst = AO + (size_t)qrow * 512 + h * 64;
#pragma unroll
    for (int dvb = 0; dvb < 2; ++dvb)
#pragma unroll
      for (int g4 = 0; g4 < 4; ++g4) {
        u32x2 o = {pack2(O[dvb][4 * g4] * inv, O[dvb][4 * g4 + 1] * inv), pack2(O[dvb][4 * g4 + 2] * inv, O[dvb][4 * g4 + 3] * inv)};
        *(u32x2*)(dst + dvb * 32 + 8 * g4 + 4 * hh) = o;
      }
  }
}

DI void phase_merge(const Params& p, char* smem) {
  char* ws = p.ws;
  const u16* YR = (const u16*)(ws + OFF_RG);
  const u16* AO = (const u16*)(ws + OFF_AO);
  const u16* GRET = (const u16*)(ws + OFF_GRET);
  const u16* GMLA = (const u16*)(ws + OFF_GMLA);
  const u16* WRET = (const u16*)(ws + OFF_WRET);
  const u16* WMLA = (const u16*)(ws + OFF_WMLA);
  u16* MG = (u16*)(ws + OFF_MG);
  const int tid = threadIdx.x, lane = tid & 63, wave = tid >> 6;
  const int wm = wave >> 1, wn = wave & 1, r = lane & 31, hh = lane >> 5;
  for (int t = blockIdx.x; t < 256 * 8; t += gridDim.x) {
    const int mt = t >> 3, nt = t & 7;
    const int m0 = mt * 128, n0 = nt * 128;
    f32x16 a1[2][2], a2[2][2];
#pragma unroll
    for (int mi = 0; mi < 2; ++mi)
#pragma unroll
      for (int ni = 0; ni < 2; ++ni) { zero_acc(a1[mi][ni]); zero_acc(a2[mi][ni]); }
    gemm_core<2>(YR + (size_t)m0 * 1024, 1024, WRET + (size_t)n0 * 1024, 1024, 1024, a1, smem);
    gemm_core<2>(AO + (size_t)m0 * 512, 512, WMLA + (size_t)n0 * 512, 512, 512, a2, smem);
#pragma unroll
    for (int mi = 0; mi < 2; ++mi)
#pragma unroll
      for (int i = 0; i < 16; ++i) {
        const int row = m0 + wm * 64 + mi * 32 + crow(i, hh);
#pragma unroll
        for (int ni = 0; ni < 2; ++ni) {
          const size_t o = (size_t)row * 1024 + n0 + wn * 64 + ni * 32 + r;
          MG[o] = f2bf(bf2f(GRET[o]) * a1[mi][ni][i] + bf2f(GMLA[o]) * a2[mi][ni][i]);
        }
      }
  }
}

DI void phase_wo(const Params& p, char* smem) {
  char* ws = p.ws;
  const u16* MG = (const u16*)(ws + OFF_MG);
  const u16* WO = (const u16*)(ws + OFF_WO);
  u16* H1B = (u16*)(ws + OFF_H1B);
  float* SS1 = (float*)(ws + OFF_SS1);
  const int tid = threadIdx.x, lane = tid & 63, wave = tid >> 6;
  const int wm = wave >> 1, wn = wave & 1, r = lane & 31, hh = lane >> 5;
  for (int t = blockIdx.x; t < 256 * 4; t += gridDim.x) {
    const int mt = t >> 2, nt = t & 3;
    const int m0 = mt * 128, n0 = nt * 256;
    f32x16 acc[2][4];
#pragma unroll
    for (int mi = 0; mi < 2; ++mi)
#pragma unroll
      for (int ni = 0; ni < 4; ++ni) zero_acc(acc[mi][ni]);
    gemm_core<4>(MG + (size_t)m0 * 1024, 1024, WO + (size_t)n0 * 1024, 1024, 1024, acc, smem);
    const int col0 = n0 + wn * 128;
#pragma unroll
    for (int mi = 0; mi < 2; ++mi)
#pragma unroll
      for (int i = 0; i < 16; ++i) {
        const int row = m0 + wm * 64 + mi * 32 + crow(i, hh);
#pragma unroll
        for (int ni = 0; ni < 4; ++ni) {
          const size_t o = (size_t)row * 1024 + col0 + ni * 32 + r;
          const float v = p.x[o] + acc[mi][ni][i];
          acc[mi][ni][i] = v;
          p.out[o] = v;
          H1B[o] = f2bf(v);
        }
      }
    rowss_partial<4>(acc, smem, SS1, 8, col0 >> 7, m0, true);
  }
}

DI void phase_gu(const Params& p, char* smem) {
  char* ws = p.ws;
  const u16* H1B = (const u16*)(ws + OFF_H1B);
  const u16* WGU = (const u16*)(ws + OFF_WGU);
  const float* SS1 = (const float*)(ws + OFF_SS1);
  u16* ACT = (u16*)(ws + OFF_ACT);
  float* sRS = (float*)(smem + 49152);
  const int tid = threadIdx.x, lane = tid & 63, wave = tid >> 6;
  const int wm = wave >> 1, wn = wave & 1, r = lane & 31, hh = lane >> 5;
  constexpr int NT = 5632 / 256;
  for (int t = blockIdx.x; t < 256 * NT; t += gridDim.x) {
    const int mt = t / NT, nt = t - mt * NT;
    const int m0 = mt * 128, n0 = nt * 256;
    __syncthreads();
    if (tid < 128) {
      const float4 a = *(const float4*)(SS1 + (size_t)(m0 + tid) * 8), b = *(const float4*)(SS1 + (size_t)(m0 + tid) * 8 + 4);
      sRS[tid] = rsqrtf((a.x + a.y + a.z + a.w + b.x + b.y + b.z + b.w) * (1.f / 1024.f) + 1e-6f);
    }
    f32x16 acc[2][4];
#pragma unroll
    for (int mi = 0; mi < 2; ++mi)
#pragma unroll
      for (int ni = 0; ni < 4; ++ni) zero_acc(acc[mi][ni]);
    gemm_core<4>(H1B + (size_t)m0 * 1024, 1024, WGU + (size_t)n0 * 1024, 1024, 1024, acc, smem);
    const int col0 = n0 + wn * 128;
#pragma unroll
    for (int mi = 0; mi < 2; ++mi)
#pragma unroll
      for (int i = 0; i < 16; ++i) {
        const int rl = wm * 64 + mi * 32 + crow(i, hh);
        const float rs = sRS[rl];
#pragma unroll
        for (int gi = 0; gi < 2; ++gi) {
          const float g = acc[mi][2 * gi][i] * rs, u = acc[mi][2 * gi + 1][i] * rs;
          ACT[(size_t)(m0 + rl) * DFF + ((col0 + gi * 64) >> 1) + r] = f2bf(siluf_(g) * u);
        }
      }
  }
}

DI void phase_down(const Params& p, char* smem) {
  char* ws = p.ws;
  const u16* ACT = (const u16*)(ws + OFF_ACT);
  const u16* WD = (const u16*)(ws + OFF_WD);
  const int tid = threadIdx.x, lane = tid & 63, wave = tid >> 6;
  const int wm = wave >> 1, wn = wave & 1, r = lane & 31, hh = lane >> 5;
  for (int t = blockIdx.x; t < 256 * 4; t += gridDim.x) {
    const int mt = t >> 2, nt = t & 3;
    const int m0 = mt * 128, n0 = nt * 256;
    f32x16 acc[2][4];
#pragma unroll
    for (int mi = 0; mi < 2; ++mi)
#pragma unroll
      for (int ni = 0; ni < 4; ++ni) zero_acc(acc[mi][ni]);
    gemm_core<4>(ACT + (size_t)m0 * DFF, DFF, WD + (size_t)n0 * DFF, DFF, DFF, acc, smem);
    const int col0 = n0 + wn * 128;
#pragma unroll
    for (int mi = 0; mi < 2; ++mi)
#pragma unroll
      for (int i = 0; i < 16; ++i) {
        const int row = m0 + wm * 64 + mi * 32 + crow(i, hh);
#pragma unroll
        for (int ni = 0; ni < 4; ++ni) {
          const size_t o = (size_t)row * 1024 + col0 + ni * 32 + r;
          p.out[o] = p.out[o] + acc[mi][ni][i];
        }
      }
  }
}

DI void phase_final(const Params& p) {
  const int gtid = blockIdx.x * 256 + threadIdx.x, gthreads = gridDim.x * 256;
  const int lane = threadIdx.x & 63;
  const int gwave = gtid >> 6, nwaves = gthreads >> 6;
  for (int row = gwave; row < M; row += nwaves) {
    float* src = p.out + (size_t)row * 1024;
    float4 v[4];
#pragma unroll
    for (int q = 0; q < 4; ++q) v[q] = *(const float4*)(src + q * 256 + lane * 4);
    float ss = 0.f;
#pragma unroll
    for (int q = 0; q < 4; ++q) ss += v[q].x * v[q].x + v[q].y * v[q].y + v[q].z * v[q].z + v[q].w * v[q].w;
    ss = wave_sum(ss);
    const float rs = rsqrtf(ss * (1.f / 1024.f) + 1e-6f);
#pragma unroll
    for (int q = 0; q < 4; ++q) {
      const float4 w = *(const float4*)(p.norm_final_w + q * 256 + lane * 4);
      float4 o = make_float4(v[q].x * rs * w.x, v[q].y * rs * w.y, v[q].z * rs * w.z, v[q].w * rs * w.w);
      *(float4*)(src + q * 256 + lane * 4) = o;
    }
  }
}

constexpr int NPHASE = 12;

__global__ void __launch_bounds__(256, 1) mega(Params p, int ph_lo, int ph_hi, int coop) {
  __shared__ __attribute__((aligned(16))) char smem[50688];
#define RUN_PHASE(k, call)                                        \
  if (ph_lo <= (k) && (k) < ph_hi) {                              \
    call;                                                         \
    if (coop && (k) + 1 < ph_hi) cg::this_grid().sync();          \
  }
  RUN_PHASE(0, phase_prep(p))
  RUN_PHASE(1, phase_proj(p, smem))
  RUN_PHASE(2, phase_ret_incr(p, smem))
  RUN_PHASE(3, phase_ret_scan(p))
  RUN_PHASE(4, phase_ret_out(p, smem))
  RUN_PHASE(5, phase_mla_proj(p, smem))
  RUN_PHASE(6, phase_attn(p, smem))
  RUN_PHASE(7, phase_merge(p, smem))
  RUN_PHASE(8, phase_wo(p, smem))
  RUN_PHASE(9, phase_gu(p, smem))
  RUN_PHASE(10, phase_down(p, smem))
  RUN_PHASE(11, phase_final(p))
}

extern "C" void kernel_launch(void* const* d_in, const int* in_sizes, int n_in, void* d_out, int out_size,
                              void* d_ws, size_t ws_size, hipStream_t stream) {
  static int grid_blocks = 0;
  if (!grid_blocks) {
    int dev = 0, cus = 0, per_cu = 0;
    hipGetDevice(&dev);
    hipDeviceGetAttribute(&cus, hipDeviceAttributeMultiprocessorCount, dev);
    hipOccupancyMaxActiveBlocksPerMultiprocessor(&per_cu, mega, 256, 0);
    if (per_cu > 1) per_cu = 1;
    if (per_cu < 1) per_cu = 1;
    grid_blocks = cus * per_cu;
  }
  Params p{};
  p.x = (const float*)d_in[0]; p.meta = (const float*)d_in[1]; p.norm_mix_w = (const float*)d_in[2];
  p.w_in = (const float*)d_in[3]; p.decay_f = (const float*)d_in[4]; p.decay_b = (const float*)d_in[5];
  p.gn_w = (const float*)d_in[6]; p.w_ret_out = (const float*)d_in[7]; p.q_norm_w = (const float*)d_in[8];
  p.w_uq = (const float*)d_in[9]; p.kv_norm_w = (const float*)d_in[10]; p.w_uk = (const float*)d_in[11];
  p.w_uv = (const float*)d_in[12]; p.w_mla_out = (const float*)d_in[13]; p.w_o = (const float*)d_in[14];
  p.norm_ffn_w = (const float*)d_in[15]; p.w_gate = (const float*)d_in[16]; p.w_up = (const float*)d_in[17];
  p.w_down = (const float*)d_in[18]; p.norm_final_w = (const float*)d_in[19];
  p.out = (float*)d_out;
  p.ws = (char*)d_ws;
  if (ws_size < WS_END) { fprintf(stderr, "workspace too small: %zu < %zu\n", ws_size, (size_t)WS_END); return; }
#if MULTI_LAUNCH
  for (int ph = 0; ph < NPHASE; ++ph) hipLaunchKernelGGL(mega, dim3(grid_blocks), dim3(256), 0, stream, p, ph, ph + 1, 0);
#else
  int lo = 0, hi = NPHASE, coop = 1;
  void* args[] = {&p, &lo, &hi, &coop};
  hipError_t e = hipLaunchCooperativeKernel((void*)mega, dim3(grid_blocks), dim3(256), args, 0, stream);
  if (e != hipSuccess) fprintf(stderr, "cooperative launch failed: %s (grid %d)\n", hipGetErrorString(e), grid_blocks);
#endif
}
```

```cpp
#include <hip/hip_runtime.h>
#include <hip/hip_cooperative_groups.h>
#include <stdint.h>
#include <cstdio>
namespace cg = cooperative_groups;

#ifndef MULTI_LAUNCH
#define MULTI_LAUNCH 0
#endif

typedef unsigned short u16;
typedef __attribute__((ext_vector_type(8))) short bf16x8;
typedef __attribute__((ext_vector_type(16))) float f32x16;
typedef __attribute__((ext_vector_type(4))) unsigned u32x4;
typedef __attribute__((ext_vector_type(2))) unsigned u32x2;
typedef __attribute__((ext_vector_type(2))) float f32x2;
typedef __attribute__((ext_vector_type(2))) __bf16 bf16x2v;

#define DI __device__ __forceinline__
#define MFMA32(a, b, c) __builtin_amdgcn_mfma_f32_32x32x16_bf16((a), (b), (c), 0, 0, 0)

constexpr int M = 32768;
constexpr int MT = 33024;
constexpr int NTHR = 512;
constexpr int SEQ = 8192;
constexpr int NPOS = 8208;
constexpr int DFF = 2816;
constexpr int NIN = 5888;

constexpr size_t SZ_WIN = (size_t)NIN * 1024 * 2;
constexpr size_t OFF_WIN = 0;
constexpr size_t OFF_WRET = OFF_WIN + SZ_WIN;
constexpr size_t OFF_WUQ = OFF_WRET + 1024 * 1024 * 2;
constexpr size_t OFF_WUKV = OFF_WUQ + 768 * 384 * 2;
constexpr size_t OFF_WMLA = OFF_WUKV + 1024 * 256 * 2;
constexpr size_t OFF_WO = OFF_WMLA + 1024 * 512 * 2;
constexpr size_t OFF_WGU = OFF_WO + 1024 * 1024 * 2;
constexpr size_t OFF_WD = OFF_WGU + (size_t)5632 * 1024 * 2;
constexpr size_t OFF_TRET = OFF_WD + (size_t)1024 * DFF * 2;
constexpr size_t OFF_TMLA = OFF_TRET + (size_t)NPOS * 32 * 8;
constexpr size_t OFF_R1 = OFF_TMLA + (size_t)NPOS * 16 * 8;
constexpr size_t SZ_U = (size_t)MT * 1024 * 2;
constexpr size_t OFF_RQ = OFF_R1 + SZ_U;
constexpr size_t OFF_RK = OFF_RQ + (size_t)M * 512 * 2;
constexpr size_t OFF_RKT = OFF_RK + (size_t)M * 512 * 2;
constexpr size_t OFF_RVT = OFF_RKT + (size_t)512 * MT * 2;
constexpr size_t OFF_RG = OFF_RVT + (size_t)1024 * MT * 2;
constexpr size_t OFF_CQ = OFF_RG + (size_t)M * 1024 * 2;
constexpr size_t OFF_CKV = OFF_CQ + (size_t)MT * 384 * 2;
constexpr size_t OFF_KR = OFF_CKV + (size_t)MT * 256 * 2;
constexpr size_t OFF_SSQ = OFF_KR + (size_t)MT * 32 * 2;
constexpr size_t OFF_SSKV = OFF_SSQ + (size_t)MT * 4 * 4;
constexpr size_t OFF_GRET = OFF_SSKV + (size_t)MT * 4 * 4;
constexpr size_t OFF_GMLA = OFF_GRET + (size_t)M * 1024 * 2;
constexpr size_t OFF_BAR = OFF_GMLA + (size_t)M * 1024 * 2;
constexpr size_t WS_END = OFF_BAR + 16384;
constexpr size_t OFF_INCR = OFF_R1;
constexpr size_t OFF_Q = OFF_R1;
constexpr size_t OFF_K = OFF_Q + (size_t)M * 768 * 2;
constexpr size_t OFF_VT = OFF_K + (size_t)32 * SEQ * 96 * 2;
constexpr size_t OFF_KM = OFF_VT + (size_t)32 * 64 * SEQ * 2;
constexpr size_t OFF_VM = OFF_KM + (size_t)8 * 64 * 96 * 2;
constexpr size_t OFF_AO = OFF_VM + (size_t)8 * 64 * 64 * 2;
constexpr size_t OFF_MG = OFF_R1;
constexpr size_t OFF_H1B = OFF_RG;
constexpr size_t OFF_SS1 = OFF_CQ;
constexpr size_t OFF_ACT = OFF_R1;
static_assert(OFF_AO + (size_t)M * 512 * 2 <= OFF_RG, "alias overflow");
static_assert(OFF_ACT + (size_t)M * DFF * 2 <= OFF_RG, "alias overflow");

struct Params {
  const float *x, *meta, *norm_mix_w, *w_in, *decay_f, *decay_b, *gn_w, *w_ret_out, *q_norm_w, *w_uq,
      *kv_norm_w, *w_uk, *w_uv, *w_mla_out, *w_o, *norm_ffn_w, *w_gate, *w_up, *w_down, *norm_final_w;
  float* out;
  char* ws;
};

DI unsigned pack2(float a, float b) {
  f32x2 v = {a, b};
  return __builtin_bit_cast(unsigned, __builtin_convertvector(v, bf16x2v));
}
DI u16 f2bf(float a) { return (u16)(pack2(a, 0.f) & 0xffffu); }
DI float bflo(unsigned u) { return __uint_as_float(u << 16); }
DI float bfhi(unsigned u) { return __uint_as_float(u & 0xffff0000u); }
DI float bf2f(u16 v) { return __uint_as_float(((unsigned)v) << 16); }
DI int otid() { int t = threadIdx.x; asm volatile("" : "+v"(t)); return t; }
DI int crow(int i, int hh) { return (i & 3) + 8 * (i >> 2) + 4 * hh; }
DI float sigmoidf_(float x) { return __builtin_amdgcn_rcpf(1.f + __builtin_amdgcn_exp2f(x * -1.4426950408889634f)); }
DI float siluf_(float x) { return x * __builtin_amdgcn_rcpf(1.f + __builtin_amdgcn_exp2f(x * -1.4426950408889634f)); }
DI float wave_sum(float v) {
#pragma unroll
  for (int o = 32; o > 0; o >>= 1) v += __shfl_xor(v, o);
  return v;
}
DI int row_pos(int row) {
  int p = row < M ? (row & (SEQ - 1)) + 16 : row - M;
  return p < NPOS ? p : NPOS - 1;
}
typedef __attribute__((ext_vector_type(2))) unsigned u32x2s;
DI void store_block32(u16* rowptr, const float (&v)[16], int hh) {
  unsigned a0 = pack2(v[0], v[1]), a1 = pack2(v[2], v[3]);
  unsigned b0 = pack2(v[4], v[5]), b1 = pack2(v[6], v[7]);
  unsigned c0 = pack2(v[8], v[9]), c1 = pack2(v[10], v[11]);
  unsigned d0 = pack2(v[12], v[13]), d1 = pack2(v[14], v[15]);
  u32x2s t;
  t = __builtin_amdgcn_permlane32_swap(a0, b0, false, false); a0 = t[0]; b0 = t[1];
  t = __builtin_amdgcn_permlane32_swap(a1, b1, false, false); a1 = t[0]; b1 = t[1];
  t = __builtin_amdgcn_permlane32_swap(c0, d0, false, false); c0 = t[0]; d0 = t[1];
  t = __builtin_amdgcn_permlane32_swap(c1, d1, false, false); c1 = t[0]; d1 = t[1];
  u32x4 lo = {a0, a1, b0, b1}, hi = {c0, c1, d0, d1};
  *(u32x4*)(rowptr + 8 * hh) = lo;
  *(u32x4*)(rowptr + 16 + 8 * hh) = hi;
}
DI void store_tokblk(u16* base, int fstride, const float (&v)[16], int hh) {
  unsigned a0 = pack2(v[0], v[1]), a1 = pack2(v[2], v[3]);
  unsigned b0 = pack2(v[4], v[5]), b1 = pack2(v[6], v[7]);
  unsigned c0 = pack2(v[8], v[9]), c1 = pack2(v[10], v[11]);
  unsigned d0 = pack2(v[12], v[13]), d1 = pack2(v[14], v[15]);
  u32x2s t;
  t = __builtin_amdgcn_permlane32_swap(a0, b0, false, false); a0 = t[0]; b0 = t[1];
  t = __builtin_amdgcn_permlane32_swap(a1, b1, false, false); a1 = t[0]; b1 = t[1];
  t = __builtin_amdgcn_permlane32_swap(c0, d0, false, false); c0 = t[0]; d0 = t[1];
  t = __builtin_amdgcn_permlane32_swap(c1, d1, false, false); c1 = t[0]; d1 = t[1];
  u32x4 lo = {a0, a1, b0, b1}, hi = {c0, c1, d0, d1};
  *(u32x4*)(base + (size_t)hh * fstride * 8) = lo;
  *(u32x4*)(base + (size_t)(2 + hh) * fstride * 8) = hi;
}
DI void zero_acc(f32x16& a) {
#pragma unroll
  for (int i = 0; i < 16; ++i) a[i] = 0.f;
}

DI int vbid() {
  const int G = gridDim.x;
  return (G & 7) ? (int)blockIdx.x : (int)(blockIdx.x & 7) * (G >> 3) + (int)(blockIdx.x >> 3);
}
DI bool tile_map(int seq, int mtiles, int NT, int& mt, int& nt) {
  const int panel = seq / (4 * NT), rem = seq - panel * 4 * NT;
  nt = rem >> 2;
  mt = panel * 4 + (rem & 3);
  return mt < mtiles;
}

typedef __attribute__((address_space(3))) void lds_void;
typedef const __attribute__((address_space(1))) void glb_void;
#define GLDS16(SRC, DST) __builtin_amdgcn_global_load_lds((glb_void*)(SRC), (lds_void*)(DST), 16, 0, 0)
#define WAIT_VM0() asm volatile("s_waitcnt vmcnt(0)" ::: "memory")
#define RAW_BARRIER() do { asm volatile("s_waitcnt lgkmcnt(0)" ::: "memory"); __builtin_amdgcn_s_barrier(); } while (0)
template <int NI, bool TR = false>
DI void gemm_core(const u16* __restrict__ A, int lda, const u16* __restrict__ Bt, int ldb, int K,
                  f32x16 (&acc)[2][NI], char* smem, bool staged = false, const u16* nA = nullptr, int nlda = 0,
                  const u16* nBt = nullptr, int nldb = 0) {
  constexpr int AB = 256 * 128;
  constexpr int BUF = AB + 64 * NI * 128;
  const int tid = otid(), lane = tid & 63, wave = tid >> 6;
  const int wm = wave >> 1, wn = wave & 1;
  const int r = lane & 31, hh = lane >> 5;
  const int lrow = tid >> 3, lc = tid & 7;
  const int rsw = (r >> 1) & 7;
  const u16* Ap = A + (size_t)lrow * lda + ((lc ^ ((lrow >> 1) & 7)) << 3);
  const u16* Bp = Bt + (size_t)lrow * ldb + ((lc ^ ((lrow >> 1) & 7)) << 3);
  char* lbase = smem + (wave << 10);
  const int nk = K >> 6;
  const int aoff = (wm * 64 + r) * 128, boff = AB + (wn * 32 * NI + r) * 128;
#define G_STAGE(ST, KT)                                                                             \
  {                                                                                                 \
    const int ko_ = (KT) * 64;                                                                      \
    char* d_ = lbase + (ST) * BUF;                                                                  \
    _Pragma("unroll") for (int p = 0; p < 4; ++p) GLDS16(Ap + (size_t)(64 * p) * lda + ko_, d_ + p * 8192);         \
    _Pragma("unroll") for (int p = 0; p < NI; ++p) GLDS16(Bp + (size_t)(64 * p) * ldb + ko_, d_ + AB + p * 8192);   \
  }
#define G_READ(FA, FB, S)                                                                           \
  {                                                                                                 \
    const int co_ = (((2 * (S) + hh) ^ rsw) << 4);                                                  \
    _Pragma("unroll") for (int mi = 0; mi < 2; ++mi) FA[mi] = *(const bf16x8*)(cur + aoff + mi * 4096 + co_);   \
    _Pragma("unroll") for (int ni = 0; ni < NI; ++ni) FB[ni] = *(const bf16x8*)(cur + boff + ni * 4096 + co_);  \
  }
#define G_MMA(FA, FB)                                                                               \
  {                                                                                                 \
    _Pragma("unroll") for (int mi = 0; mi < 2; ++mi)                                                \
      _Pragma("unroll") for (int ni = 0; ni < NI; ++ni)                                             \
        acc[mi][ni] = TR ? MFMA32(FB[ni], FA[mi], acc[mi][ni]) : MFMA32(FA[mi], FB[ni], acc[mi][ni]);           \
  }
  if (!staged) {
    __syncthreads();
    G_STAGE(0, 0)
  }
  WAIT_VM0();
  __syncthreads();
  for (int kt = 0; kt < nk; ++kt) {
    const char* cur = smem + (kt & 1) * BUF;
    bf16x8 fa0[2], fb0[NI], fa1[2], fb1[NI];
    if (kt + 1 < nk) G_STAGE((kt + 1) & 1, kt + 1)
    else if (nA) {
      const u16* nAp = nA + (size_t)lrow * nlda + ((lc ^ ((lrow >> 1) & 7)) << 3);
      const u16* nBp = nBt + (size_t)lrow * nldb + ((lc ^ ((lrow >> 1) & 7)) << 3);
      _Pragma("unroll") for (int p = 0; p < 4; ++p) GLDS16(nAp + (size_t)(64 * p) * nlda, lbase + p * 8192);
      _Pragma("unroll") for (int p = 0; p < NI; ++p) GLDS16(nBp + (size_t)(64 * p) * nldb, lbase + AB + p * 8192);
    }
    G_READ(fa0, fb0, 0)
    __builtin_amdgcn_sched_barrier(0);
    G_READ(fa1, fb1, 1)
    G_MMA(fa0, fb0)
    __builtin_amdgcn_sched_barrier(0);
    G_READ(fa0, fb0, 2)
    G_MMA(fa1, fb1)
    __builtin_amdgcn_sched_barrier(0);
    G_READ(fa1, fb1, 3)
    G_MMA(fa0, fb0)
    __builtin_amdgcn_sched_barrier(0);
    G_MMA(fa1, fb1)
    __builtin_amdgcn_sched_barrier(0);
    if (kt + 1 < nk) {
      WAIT_VM0();
      __syncthreads();
    } else {
      asm volatile("s_waitcnt lgkmcnt(0)" ::: "memory");
      __builtin_amdgcn_s_barrier();
    }
  }
#undef G_STAGE
#undef G_READ
#undef G_MMA
}

#define WAIT_V8(n) asm volatile("s_waitcnt vmcnt(" #n ")" ::: "memory")
#define WAIT_L8(n) asm volatile("s_waitcnt lgkmcnt(" #n ")" ::: "memory")
#define BAR8 __builtin_amdgcn_s_barrier()
#define SCHED8 __builtin_amdgcn_sched_barrier(0)
template <bool TR>
DI void gemm8(const u16* __restrict__ A, int lda, const u16* __restrict__ Bt, int ldb, int K,
              f32x16 (&acc)[2][4], char* smem) {
  const int tid = otid(), lane = tid & 63, wave = tid >> 6;
  const int r = lane & 31, hh = lane >> 5;
  const int grp = __builtin_amdgcn_readfirstlane(wave) >> 2;
  const int ir0 = wave * 8 + (lane >> 3), ir1 = ir0 + 64;
  const int csrc = ((lane & 7) ^ ((ir0 >> 1) & 7)) << 3;
  const unsigned vA0 = (unsigned)(((ir0 >> 5) * 64 + (ir0 & 31)) * lda + csrc) * 2u;
  const unsigned vA1 = (unsigned)(((ir1 >> 5) * 64 + (ir1 & 31)) * lda + csrc) * 2u;
  const unsigned vB0 = (unsigned)(((ir0 >> 6) * 128 + (ir0 & 63)) * ldb + csrc) * 2u;
  const unsigned vB1 = (unsigned)(((ir1 >> 6) * 128 + (ir1 & 63)) * ldb + csrc) * 2u;
  const int rsw = (r >> 1) & 7;
  typedef const __attribute__((address_space(3))) bf16x8 lds_frag;
  const unsigned sbase = (unsigned)(size_t)(lds_void*)smem;
  const unsigned lb = __builtin_amdgcn_readfirstlane(sbase + (wave << 10));
  unsigned aad[4], bad[4];
#pragma unroll
  for (int s = 0; s < 4; ++s) {
    aad[s] = sbase + ((wave >> 1) * 32 + r) * 128 + (((2 * s + hh) ^ rsw) << 4);
    bad[s] = sbase + 65536 + ((wave & 1) * 64 + r) * 128 + (((2 * s + hh) ^ rsw) << 4);
  }
#define SA8(b, h) (((b) * 2 + (h)) * 16384)
#define SB8(b, h) ((4 + (b) * 2 + (h)) * 16384)
#define STAGE_A8(b, h, kt)                                                                       \
  {                                                                                              \
    const char* sb_ = (const char*)A + ((size_t)((h) * 32) * lda + (size_t)(kt) * 64) * 2;       \
    __builtin_amdgcn_global_load_lds((glb_void*)(sb_ + vA0), (lds_void*)(size_t)(lb + SA8(b, h)), 16, 0, 0);                                                        \
    __builtin_amdgcn_global_load_lds((glb_void*)(sb_ + vA1), (lds_void*)(size_t)(lb + SA8(b, h) + 8192), 16, 0, 0);                                                 \
  }
#define STAGE_B8(b, h, kt)                                                                       \
  {                                                                                              \
    const char* sb_ = (const char*)Bt + ((size_t)((h) * 64) * ldb + (size_t)(kt) * 64) * 2;      \
    __builtin_amdgcn_global_load_lds((glb_void*)(sb_ + vB0), (lds_void*)(size_t)(lb + SB8(b, h)), 16, 0, 0);                                                        \
    __builtin_amdgcn_global_load_lds((glb_void*)(sb_ + vB1), (lds_void*)(size_t)(lb + SB8(b, h) + 8192), 16, 0, 0);                                                 \
  }
#define LDA8(AT, b, h)                                                                           \
  { _Pragma("unroll") for (int s = 0; s < 4; ++s) AT[s] = *(lds_frag*)(aad[s] + SA8(b, h)); }
#define LDB8(BX, b, h)                                                                           \
  { _Pragma("unroll") for (int nl = 0; nl < 2; ++nl)                                             \
      _Pragma("unroll") for (int s = 0; s < 4; ++s) BX[nl][s] = *(lds_frag*)(bad[s] + ((b) * 2 + (h)) * 16384 + nl * 4096); }
#define MMA8(ai, bj, AT, BX)                                                                     \
  {                                                                                              \
    __builtin_amdgcn_s_setprio(1);                                                               \
    _Pragma("unroll") for (int s = 0; s < 4; ++s)                                                \
      _Pragma("unroll") for (int nl = 0; nl < 2; ++nl)                                           \
        acc[ai][2 * (bj) + nl] = TR ? MFMA32(BX[nl][s], AT[s], acc[ai][2 * (bj) + nl]) : MFMA32(AT[s], BX[nl][s], acc[ai][2 * (bj) + nl]);  \
    __builtin_amdgcn_s_setprio(0);                                                               \
  }
#define LD_RA(X, b, h) LDB8(X, b, h)
#define LD_RB(X, b, h) LDA8(X, b, h)
#define ST_RA(b, h, kt) STAGE_B8(b, h, kt)
#define ST_RB(b, h, kt) STAGE_A8(b, h, kt)
#define MM(ra, rb, XA, XB) MMA8(rb, ra, XB, XA)
  bf16x8 Wf[2][4], X0[4], X1[4];
  const int nt = K >> 6;
  RAW_BARRIER();
  ST_RB(0, 0, 0) ST_RA(0, 0, 0) ST_RB(0, 1, 0) ST_RA(0, 1, 0)
  if (grp == 1) BAR8;
  WAIT_V8(4); BAR8;
  ST_RB(1, 0, 1) ST_RA(1, 0, 1) ST_RB(1, 1, 1)
  WAIT_V8(6); BAR8;
  for (int t = 0; t < nt - 2; t += 2) {
    LD_RB(X0, 0, 0) SCHED8; LD_RA(Wf, 0, 0) ST_RA(1, 1, t + 1)
    WAIT_L8(8); BAR8; WAIT_L8(0); MM(0, 0, Wf, X0) BAR8; SCHED8;
    LD_RB(X1, 0, 1) ST_RB(0, 0, t + 2)
    BAR8; WAIT_L8(0); MM(0, 1, Wf, X1) BAR8;
    LD_RA(Wf, 0, 1) ST_RA(0, 0, t + 2)
    BAR8; WAIT_L8(0); MM(1, 0, Wf, X0) BAR8; SCHED8;
    ST_RB(0, 1, t + 2)
    WAIT_V8(6); BAR8; MM(1, 1, Wf, X1) BAR8;
    LD_RB(X0, 1, 0) SCHED8; LD_RA(Wf, 1, 0) ST_RA(0, 1, t + 2)
    WAIT_L8(8); BAR8; WAIT_L8(0); MM(0, 0, Wf, X0) BAR8; SCHED8;
    LD_RB(X1, 1, 1) ST_RB(1, 0, t + 3)
    BAR8; WAIT_L8(0); MM(0, 1, Wf, X1) BAR8;
    LD_RA(Wf, 1, 1) ST_RA(1, 0, t + 3)
    BAR8; WAIT_L8(0); MM(1, 0, Wf, X0) BAR8; SCHED8;
    ST_RB(1, 1, t + 3)
    WAIT_V8(6); BAR8; MM(1, 1, Wf, X1) BAR8;
  }
  {
    LD_RB(X0, 0, 0) LD_RA(Wf, 0, 0) ST_RA(1, 1, nt - 1)
    BAR8; WAIT_L8(0); MM(0, 0, Wf, X0) BAR8;
    LD_RB(X1, 0, 1) BAR8; WAIT_L8(0); MM(0, 1, Wf, X1) BAR8;
    LD_RA(Wf, 0, 1) WAIT_V8(4); BAR8; WAIT_L8(0); MM(1, 0, Wf, X0) MM(1, 1, Wf, X1) BAR8;
  }
  {
    LD_RB(X0, 1, 0) LD_RA(Wf, 1, 0) WAIT_V8(2); BAR8; WAIT_L8(0); MM(0, 0, Wf, X0) BAR8;
    LD_RB(X1, 1, 1) WAIT_V8(0); BAR8; WAIT_L8(0); MM(0, 1, Wf, X1) BAR8;
    LD_RA(Wf, 1, 1) BAR8; WAIT_L8(0); MM(1, 0, Wf, X0) MM(1, 1, Wf, X1) BAR8;
  }
  if (grp == 0) BAR8;
#undef LD_RA
#undef LD_RB
#undef ST_RA
#undef ST_RB
#undef MM
#undef SA8
#undef SB8
#undef STAGE_A8
#undef STAGE_B8
#undef LDA8
#undef LDB8
#undef MMA8
}

template <int NI>
DI void rowss_partial(f32x16 (&acc)[2][NI], char* smem, float* ss, int stride, int slab, int row0, bool doit) {
  const int tid = otid(), lane = tid & 63, wave = tid >> 6;
  const int r = lane & 31, hh = lane >> 5;
  float* sw = (float*)(smem + 65536) + wave * (64 * 33);
#pragma unroll
  for (int mi = 0; mi < 2; ++mi)
#pragma unroll
    for (int i = 0; i < 16; ++i) {
      float t = 0.f;
#pragma unroll
      for (int ni = 0; ni < NI; ++ni) t += acc[mi][ni][i] * acc[mi][ni][i];
      sw[(mi * 32 + crow(i, hh)) * 33 + r] = t;
    }
  __syncthreads();
  float t = 0.f;
#pragma unroll
  for (int j = 0; j < 32; ++j) t += sw[lane * 33 + j];
  if (doit) ss[(size_t)(row0 + (wave >> 1) * 64 + lane) * stride + slab] = t;
  __syncthreads();
}

DI void phase_prep(const Params& p, char* smem) {
  char* ws = p.ws;
  const int gtid = blockIdx.x * NTHR + threadIdx.x, gthreads = gridDim.x * NTHR;
  const int lane = threadIdx.x & 63;
  const int gwave = gtid >> 6, nwaves = gthreads >> 6;
  u16* U = (u16*)(ws + OFF_R1);
  {
    float4 w[4];
    w[0] = *(const float4*)(p.norm_mix_w + lane * 8);
    w[1] = *(const float4*)(p.norm_mix_w + lane * 8 + 4);
    w[2] = *(const float4*)(p.norm_mix_w + 512 + lane * 8);
    w[3] = *(const float4*)(p.norm_mix_w + 512 + lane * 8 + 4);
    for (int row0 = gwave * 4; row0 < MT; row0 += nwaves * 4) {
      const bool live = row0 < M + 16;
      float4 v[4][4];
      if (live) {
#pragma unroll
        for (int k = 0; k < 4; ++k) {
          const int row = row0 + k;
          const float* src = row < M ? p.x + (size_t)row * 1024 : p.meta + (size_t)(row - M) * 1024;
          v[k][0] = *(const float4*)(src + lane * 8);
          v[k][1] = *(const float4*)(src + lane * 8 + 4);
          v[k][2] = *(const float4*)(src + 512 + lane * 8);
          v[k][3] = *(const float4*)(src + 512 + lane * 8 + 4);
        }
      }
#pragma unroll
      for (int k = 0; k < 4; ++k) {
        u32x4 o0 = {0, 0, 0, 0}, o1 = {0, 0, 0, 0};
        if (live) {
          float ss = 0.f;
#pragma unroll
          for (int q = 0; q < 4; ++q) ss += v[k][q].x * v[k][q].x + v[k][q].y * v[k][q].y + v[k][q].z * v[k][q].z + v[k][q].w * v[k][q].w;
          ss = wave_sum(ss);
          const float rs = rsqrtf(ss * (1.f / 1024.f) + 1e-6f);
          o0[0] = pack2(v[k][0].x * rs * w[0].x, v[k][0].y * rs * w[0].y);
          o0[1] = pack2(v[k][0].z * rs * w[0].z, v[k][0].w * rs * w[0].w);
          o0[2] = pack2(v[k][1].x * rs * w[1].x, v[k][1].y * rs * w[1].y);
          o0[3] = pack2(v[k][1].z * rs * w[1].z, v[k][1].w * rs * w[1].w);
          o1[0] = pack2(v[k][2].x * rs * w[2].x, v[k][2].y * rs * w[2].y);
          o1[1] = pack2(v[k][2].z * rs * w[2].z, v[k][2].w * rs * w[2].w);
          o1[2] = pack2(v[k][3].x * rs * w[3].x, v[k][3].y * rs * w[3].y);
          o1[3] = pack2(v[k][3].z * rs * w[3].z, v[k][3].w * rs * w[3].w);
        }
        *(u32x4*)(U + (size_t)(row0 + k) * 1024 + lane * 8) = o0;
        *(u32x4*)(U + (size_t)(row0 + k) * 1024 + 512 + lane * 8) = o1;
      }
    }
  }
  {
    float2* tr = (float2*)(ws + OFF_TRET);
    for (int idx = gtid; idx < NPOS * 32; idx += gthreads) {
      const int pos = idx >> 5, i = idx & 31;
      const float inv = (float)pow(10000.0, -(double)i / 32.0);
      const float ang = (float)pos * inv;
      tr[idx] = make_float2((float)cos((double)ang), (float)sin((double)ang));
    }
    float2* tm = (float2*)(ws + OFF_TMLA);
    for (int idx = gtid; idx < NPOS * 16; idx += gthreads) {
      const int pos = idx >> 4, i = idx & 15;
      const float inv = (float)pow(10000.0, -(double)i / 16.0);
      const float ang = (float)pos * inv;
      tm[idx] = make_float2((float)cos((double)ang), (float)sin((double)ang));
    }
  }
  {
    const int wave = threadIdx.x >> 6;
    char* sT = smem + wave * 9216;
    int base = 0;
    for (int job = 0; job < 8; ++job) {
      int N, K;
      u16* dst;
      switch (job) {
        case 0: N = NIN; K = 1024; dst = (u16*)(ws + OFF_WIN); break;
        case 1: N = 1024; K = 1024; dst = (u16*)(ws + OFF_WRET); break;
        case 2: N = 768; K = 384; dst = (u16*)(ws + OFF_WUQ); break;
        case 3: N = 1024; K = 256; dst = (u16*)(ws + OFF_WUKV); break;
        case 4: N = 1024; K = 512; dst = (u16*)(ws + OFF_WMLA); break;
        case 5: N = 1024; K = 1024; dst = (u16*)(ws + OFF_WO); break;
        case 6: N = 5632; K = 1024; dst = (u16*)(ws + OFF_WGU); break;
        default: N = 1024; K = DFF; dst = (u16*)(ws + OFF_WD); break;
      }
      const int ntn = N >> 6, ntiles = ntn * (K >> 6);
      int first = gwave - (base % nwaves);
      if (first < 0) first += nwaves;
      for (int tl = first; tl < ntiles; tl += nwaves) {
        const int kt = tl / ntn, n = (tl - kt * ntn) * 64 + lane, k0 = kt * 64;
        const float* src = nullptr;
        int ld = 0;
        const float* scale = nullptr;
        switch (job) {
          case 0: {
            ld = 5792;
            if (n < 3712) src = p.w_in + n;
            else if (n < 5760) src = p.w_in + n + 32;
            else if (n < 5824) {
              const int c = n - 5760;
              if (c < 16) src = p.w_in + 3712 + c;
              else if (c >= 32 && c < 48) src = p.w_in + 3712 + 16 + (c - 32);
            }
          } break;
          case 1: ld = 1024; src = p.w_ret_out + n; scale = p.gn_w; break;
          case 2: {
            ld = 768;
            scale = p.q_norm_w;
            if (n < 512) src = p.w_uq + (n >> 6) * 96 + (n & 63);
            else {
              const int g = (n - 512) >> 6, c = (n - 512) & 63;
              const int half = c >> 5, hsel = (c >> 4) & 1, j = c & 15;
              src = p.w_uq + (2 * g + hsel) * 96 + 64 + half * 16 + j;
            }
          } break;
          case 3: ld = 512; scale = p.kv_norm_w; src = n < 512 ? p.w_uk + n : p.w_uv + (n - 512); break;
          case 4: ld = 1024; src = p.w_mla_out + n; break;
          case 5: ld = 1024; src = p.w_o + n; break;
          case 6: {
            ld = DFF;
            scale = p.norm_ffn_w;
            const int blk = n >> 6, c = n & 63;
            src = c < 32 ? p.w_gate + blk * 32 + c : p.w_up + blk * 32 + (c - 32);
          } break;
          default: ld = 1024; src = p.w_down + n; break;
        }
        float v[64];
#pragma unroll
        for (int j = 0; j < 64; ++j) v[j] = src ? src[(size_t)(k0 + j) * ld] : 0.f;
        if (scale) {
          const float sc = scale[k0 + lane];
#pragma unroll
          for (int j = 0; j < 64; ++j) v[j] *= __shfl(sc, j);
        }
#pragma unroll
        for (int j = 0; j < 32; ++j) *(unsigned*)(sT + lane * 144 + j * 4) = pack2(v[2 * j], v[2 * j + 1]);
#pragma unroll
        for (int q = 0; q < 8; ++q) {
          const int row = q * 8 + (lane >> 3), c = lane & 7;
          const u32x4 o = *(const u32x4*)(sT + row * 144 + c * 16);
          *(u32x4*)(dst + (size_t)((tl - kt * ntn) * 64 + row) * K + k0 + c * 8) = o;
        }
      }
      base += ntiles;
    }
  }
}

DI void phase_proj(const Params& p, char* smem) {
  char* ws = p.ws;
  const u16* U = (const u16*)(ws + OFF_R1);
  const u16* W = (const u16*)(ws + OFF_WIN);
  u16* RQ = (u16*)(ws + OFF_RQ);
  u16* RK = (u16*)(ws + OFF_RK);
  u16* RKT = (u16*)(ws + OFF_RKT);
  u16* RVT = (u16*)(ws + OFF_RVT);
  u16* RG = (u16*)(ws + OFF_RG);
  u16* CQ = (u16*)(ws + OFF_CQ);
  u16* CKV = (u16*)(ws + OFF_CKV);
  u16* KR = (u16*)(ws + OFF_KR);
  u16* GRET = (u16*)(ws + OFF_GRET);
  u16* GMLA = (u16*)(ws + OFF_GMLA);
  float* SSQ = (float*)(ws + OFF_SSQ);
  float* SSKV = (float*)(ws + OFF_SSKV);
  const float2* TR = (const float2*)(ws + OFF_TRET);
  const float2* TM = (const float2*)(ws + OFF_TMLA);
  const int tid = otid(), lane = tid & 63, wave = tid >> 6;
  const int wm = wave >> 1, wn = wave & 1, r = lane & 31, hh = lane >> 5;
  constexpr int NT = NIN / 256;
  constexpr int LIM = 33 * 4 * NT;
  int tfirst = vbid();
  {
    int mt_, nt_;
    while (tfirst < LIM && !tile_map(tfirst, MT / 256, NT, mt_, nt_)) tfirst += gridDim.x;
  }
  bool staged = false;
  for (int t = tfirst, tn = 0; t < LIM; t = tn) {
    int mt, nt;
    tile_map(t, MT / 256, NT, mt, nt);
    const int m0 = mt * 256, n0 = nt * 256;
    const u16 *nA = nullptr, *nB = nullptr;
    {
      int mt2 = 0, nt2 = 0;
      tn = t + gridDim.x;
      while (tn < LIM && !tile_map(tn, MT / 256, NT, mt2, nt2)) tn += gridDim.x;
      if (tn < LIM) { nA = U + (size_t)mt2 * 256 * 1024; nB = W + (size_t)nt2 * 256 * 1024; }
    }
    f32x16 acc[2][4];
#pragma unroll
    for (int mi = 0; mi < 2; ++mi)
#pragma unroll
      for (int ni = 0; ni < 4; ++ni) zero_acc(acc[mi][ni]);
    gemm8<false>(U + (size_t)m0 * 1024, 1024, W + (size_t)n0 * 1024, 1024, 1024, acc, smem);
    const int col0 = n0 + wn * 128;
    const int rowb = m0 + wm * 64;
    if (n0 >= 3072 && n0 < 3712) {
      const bool isq = col0 < 3456;
      const bool iskv = col0 >= 3456 && col0 < 3712;
      rowss_partial<4>(acc, smem, isq ? SSQ : SSKV, 4, isq ? (col0 - 3072) >> 7 : (col0 - 3456) >> 7, m0, isq || iskv);
    }
    if (col0 < 1024) {
      const bool isk = col0 >= 512;
#pragma unroll
      for (int mi = 0; mi < 2; ++mi) {
        float o1[2][16], o2[2][16];
#pragma unroll
        for (int i = 0; i < 16; ++i) {
          const int row = rowb + mi * 32 + crow(i, hh);
          const float2 cs = TR[row_pos(row) * 32 + r];
#pragma unroll
          for (int gi = 0; gi < 2; ++gi) {
            float x1 = acc[mi][2 * gi][i], x2 = acc[mi][2 * gi + 1][i];
            float a = x1 * cs.x - x2 * cs.y, b = x1 * cs.y + x2 * cs.x;
            if (isk) { a *= 0.125f; b *= 0.125f; }
            o1[gi][i] = a; o2[gi][i] = b;
          }
        }
        const int rowm = rowb + mi * 32;
#pragma unroll
        for (int gi = 0; gi < 2; ++gi) {
          const int hc = (col0 & 511) + gi * 64;
          if (rowm < M) {
            u16* dst = (isk ? RK : RQ) + (size_t)(rowm + 4 * hh) * 512 + hc + r;
#pragma unroll
            for (int i = 0; i < 16; ++i) {
              const int ro = (i & 3) + 8 * (i >> 2);
              dst[(size_t)ro * 512] = f2bf(o1[gi][i]);
              dst[(size_t)ro * 512 + 32] = f2bf(o2[gi][i]);
            }
          }
          if (isk) {
            store_tokblk(RKT + ((size_t)(rowm >> 3) * 512 + hc + r) * 8, 512, o1[gi], hh);
            store_tokblk(RKT + ((size_t)(rowm >> 3) * 512 + hc + 32 + r) * 8, 512, o2[gi], hh);
          }
        }
      }
    } else if (col0 < 2048) {
#pragma unroll
      for (int mi = 0; mi < 2; ++mi)
#pragma unroll
        for (int ni = 0; ni < 4; ++ni) {
          float v[16];
#pragma unroll
          for (int i = 0; i < 16; ++i) v[i] = acc[mi][ni][i];
          store_tokblk(RVT + ((size_t)((rowb + mi * 32) >> 3) * 1024 + (col0 - 1024 + ni * 32 + r)) * 8, 1024, v, hh);
        }
    } else if (col0 < 3072) {
      u16* dstb = RG + (col0 - 2048);
#pragma unroll
      for (int mi = 0; mi < 2; ++mi)
#pragma unroll
        for (int i = 0; i < 16; ++i) {
          const int row = rowb + mi * 32 + crow(i, hh);
          if (row < M) {
#pragma unroll
            for (int ni = 0; ni < 4; ++ni) dstb[(size_t)row * 1024 + ni * 32 + r] = f2bf(siluf_(acc[mi][ni][i]));
          }
        }
    } else if (col0 >= 3712 && col0 < 5760) {
      if (m0 < M) {
        const bool isret = col0 < 4736;
        u16* gb = isret ? GRET : GMLA;
        const int cb = (col0 - (isret ? 3712 : 4736)) >> 5;
        const int R = rowb >> 6;
#pragma unroll
        for (int mi = 0; mi < 2; ++mi)
#pragma unroll
          for (int ni = 0; ni < 4; ++ni) {
            u32x4 o0, o1;
            o0[0] = pack2(sigmoidf_(acc[mi][ni][0]), sigmoidf_(acc[mi][ni][1]));
            o0[1] = pack2(sigmoidf_(acc[mi][ni][2]), sigmoidf_(acc[mi][ni][3]));
            o0[2] = pack2(sigmoidf_(acc[mi][ni][4]), sigmoidf_(acc[mi][ni][5]));
            o0[3] = pack2(sigmoidf_(acc[mi][ni][6]), sigmoidf_(acc[mi][ni][7]));
            o1[0] = pack2(sigmoidf_(acc[mi][ni][8]), sigmoidf_(acc[mi][ni][9]));
            o1[1] = pack2(sigmoidf_(acc[mi][ni][10]), sigmoidf_(acc[mi][ni][11]));
            o1[2] = pack2(sigmoidf_(acc[mi][ni][12]), sigmoidf_(acc[mi][ni][13]));
            o1[3] = pack2(sigmoidf_(acc[mi][ni][14]), sigmoidf_(acc[mi][ni][15]));
            u16* d = gb + ((((size_t)R * 32 + cb + ni) * 2 + mi) * 64 + lane) * 16;
            *(u32x4*)d = o0;
            *(u32x4*)(d + 8) = o1;
          }
      }
    } else if (col0 < 3712) {
      const bool isq = col0 < 3456;
      u16* dstb = isq ? CQ + (col0 - 3072) : CKV + (col0 - 3456);
      const int ld = isq ? 384 : 256;
#pragma unroll
      for (int mi = 0; mi < 2; ++mi)
#pragma unroll
        for (int i = 0; i < 16; ++i) {
          const int row = rowb + mi * 32 + crow(i, hh);
#pragma unroll
          for (int ni = 0; ni < 4; ++ni) dstb[(size_t)row * ld + ni * 32 + r] = f2bf(acc[mi][ni][i]);
        }
    } else if (col0 == 5760) {
      if (r < 16) {
#pragma unroll
        for (int mi = 0; mi < 2; ++mi)
#pragma unroll
          for (int i = 0; i < 16; ++i) {
            const int row = rowb + mi * 32 + crow(i, hh);
            const float2 cs = TM[row_pos(row) * 16 + r];
            const float x1 = acc[mi][0][i], x2 = acc[mi][1][i];
            KR[(size_t)row * 32 + r] = f2bf(x1 * cs.x - x2 * cs.y);
            KR[(size_t)row * 32 + 16 + r] = f2bf(x1 * cs.y + x2 * cs.x);
          }
      }
    }
  }
}

DI void phase_ret_incr(const Params& p, char* smem) {
  char* ws = p.ws;
  const u16* RKT = (const u16*)(ws + OFF_RKT);
  const u16* RVT = (const u16*)(ws + OFF_RVT);
  u16* INCR = (u16*)(ws + OFF_INCR);
  const int half = threadIdx.x >> 8;
  smem += half * 51200;
  char* sV = smem;
  char* sK = smem + 32768;
  float* sW = (float*)(smem + 49152);
  const int tid = otid() & 255, lane = tid & 63, wave = tid >> 6;
  const int r = lane & 31, hh = lane >> 5;
  const float LOG2E = 1.4426950408889634f;
  for (int pi = blockIdx.x; pi < 4 * 64 * 4; pi += gridDim.x) {
    const int item = 2 * pi + half;
    const int h = item & 7, c = (item >> 3) & 63, b = item >> 9;
    const int col0 = b * SEQ + c * 128;
    const float lgf2 = -__expf(p.decay_f[h]) * LOG2E, lgb2 = -__expf(p.decay_b[h]) * LOG2E;
    __syncthreads();
    if (tid < 128) {
      sW[tid] = exp2f(lgf2 * (float)(127 - tid));
      sW[128 + tid] = exp2f(lgb2 * (float)tid);
    }
    {
      const int tb0 = col0 >> 3;
      const int ve = tid & 127, vc0 = tid >> 7;
#pragma unroll
      for (int q = 0; q < 8; ++q) {
        const int c_ = vc0 + 2 * q;
        u32x4 v = *(const u32x4*)(RVT + ((size_t)(tb0 + c_) * 1024 + h * 128 + ve) * 8);
        *(u32x4*)(sV + ve * 256 + ((c_ ^ (ve & 15)) << 4)) = v;
      }
      const int kd = tid & 63, kc0 = tid >> 6;
#pragma unroll
      for (int q = 0; q < 4; ++q) {
        const int c_ = kc0 + 4 * q;
        u32x4 v = *(const u32x4*)(RKT + ((size_t)(tb0 + c_) * 512 + h * 64 + kd) * 8);
        *(u32x4*)(sK + kd * 256 + ((c_ ^ (kd & 15)) << 4)) = v;
      }
    }
    __syncthreads();
    f32x16 af[2], ab[2];
    zero_acc(af[0]); zero_acc(af[1]); zero_acc(ab[0]); zero_acc(ab[1]);
#pragma unroll
    for (int s = 0; s < 8; ++s) {
      const int ch = 2 * s + hh;
      const int e = wave * 32 + r;
      const bf16x8 a = *(const bf16x8*)(sV + e * 256 + ((ch ^ (e & 15)) << 4));
      const float4 wf0 = *(const float4*)(sW + ch * 8), wf1 = *(const float4*)(sW + ch * 8 + 4);
      const float4 wb0 = *(const float4*)(sW + 128 + ch * 8), wb1 = *(const float4*)(sW + 128 + ch * 8 + 4);
#pragma unroll
      for (int nb = 0; nb < 2; ++nb) {
        const int d = nb * 32 + r;
        const u32x4 kv = *(const u32x4*)(sK + d * 256 + ((ch ^ (d & 15)) << 4));
        u32x4 kf, kb;
        kf[0] = pack2(bflo(kv[0]) * wf0.x, bfhi(kv[0]) * wf0.y);
        kf[1] = pack2(bflo(kv[1]) * wf0.z, bfhi(kv[1]) * wf0.w);
        kf[2] = pack2(bflo(kv[2]) * wf1.x, bfhi(kv[2]) * wf1.y);
        kf[3] = pack2(bflo(kv[3]) * wf1.z, bfhi(kv[3]) * wf1.w);
        kb[0] = pack2(bflo(kv[0]) * wb0.x, bfhi(kv[0]) * wb0.y);
        kb[1] = pack2(bflo(kv[1]) * wb0.z, bfhi(kv[1]) * wb0.w);
        kb[2] = pack2(bflo(kv[2]) * wb1.x, bfhi(kv[2]) * wb1.y);
        kb[3] = pack2(bflo(kv[3]) * wb1.z, bfhi(kv[3]) * wb1.w);
        af[nb] = MFMA32(a, __builtin_bit_cast(bf16x8, kf), af[nb]);
        ab[nb] = MFMA32(a, __builtin_bit_cast(bf16x8, kb), ab[nb]);
      }
    }
    const int fslot = c <= 62 ? c + 1 : -1;
    const int bslot = c >= 1 ? c - 1 : -1;
#pragma unroll
    for (int nb = 0; nb < 2; ++nb)
#pragma unroll
      for (int i = 0; i < 16; ++i) {
        const int e = wave * 32 + crow(i, hh), d = nb * 32 + r;
        if (fslot >= 0) INCR[((size_t)((0 * 4 + b) * 64 + fslot) * 8 + h) * 8192 + e * 64 + d] = f2bf(af[nb][i]);
        if (bslot >= 0) INCR[((size_t)((1 * 4 + b) * 64 + bslot) * 8 + h) * 8192 + e * 64 + d] = f2bf(ab[nb][i]);
      }
  }
}

DI void phase_ret_scan(const Params& p) {
  unsigned* INCR = (unsigned*)(p.ws + OFF_INCR);
  const int gtid = blockIdx.x * NTHR + threadIdx.x, gthreads = gridDim.x * NTHR;
  const float LOG2E = 1.4426950408889634f;
  for (int idx = gtid; idx < 2 * 4 * 8 * 4096; idx += gthreads) {
    const int pr = idx & 4095, h = (idx >> 12) & 7, b = (idx >> 15) & 3, dir = idx >> 17;
    const float lg2 = -__expf(dir ? p.decay_b[h] : p.decay_f[h]) * LOG2E;
    const float g = exp2f(lg2 * 128.f);
    unsigned* base = INCR + (size_t)(dir * 4 + b) * 64 * 8 * 4096 + (size_t)h * 4096 + pr;
    float s0 = 0.f, s1 = 0.f;
    if (dir) {
      base[(size_t)63 * 8 * 4096] = 0u;
    } else {
      const int e = pr >> 5, d = (pr & 31) * 2;
      const u16* RKT = (const u16*)(p.ws + OFF_RKT);
      const u16* RVT = (const u16*)(p.ws + OFF_RVT);
#pragma unroll
      for (int tb = 0; tb < 2; ++tb) {
        const u32x4 vv = *(const u32x4*)(RVT + ((size_t)((M >> 3) + tb) * 1024 + h * 128 + e) * 8);
        const u32x4 k0 = *(const u32x4*)(RKT + ((size_t)((M >> 3) + tb) * 512 + h * 64 + d) * 8);
        const u32x4 k1 = *(const u32x4*)(RKT + ((size_t)((M >> 3) + tb) * 512 + h * 64 + d + 1) * 8);
#pragma unroll
        for (int j = 0; j < 4; ++j) {
          const float w0 = exp2f(lg2 * (float)(15 - (tb * 8 + 2 * j))), w1 = exp2f(lg2 * (float)(15 - (tb * 8 + 2 * j + 1)));
          s0 += w0 * bflo(vv[j]) * bflo(k0[j]) + w1 * bfhi(vv[j]) * bfhi(k0[j]);
          s1 += w0 * bflo(vv[j]) * bflo(k1[j]) + w1 * bfhi(vv[j]) * bfhi(k1[j]);
        }
      }
      base[0] = pack2(s0, s1);
    }
#pragma unroll 1
    for (int bt = 0; bt < 4; ++bt) {
      unsigned* q = dir ? base + (size_t)(62 - bt * 16) * 8 * 4096 : base + (size_t)(1 + bt * 16) * 8 * 4096;
      const long st = dir ? -(long)(8 * 4096) : (long)(8 * 4096);
      const int cnt = bt == 3 ? 15 : 16;
      unsigned u[16];
#pragma unroll
      for (int n = 0; n < 16; ++n) u[n] = (n < cnt) ? q[n * st] : 0u;
#pragma unroll
      for (int n = 0; n < 16; ++n) {
        s0 = g * s0 + bflo(u[n]); s1 = g * s1 + bfhi(u[n]);
        u[n] = pack2(s0, s1);
      }
#pragma unroll
      for (int n = 0; n < 16; ++n) if (n < cnt) q[n * st] = u[n];
    }
  }
}

DI void phase_ret_out(const Params& p, char* smem) {
  char* ws = p.ws;
  const u16* RQ = (const u16*)(ws + OFF_RQ);
  const u16* RK = (const u16*)(ws + OFF_RK);
  const u16* RVT = (const u16*)(ws + OFF_RVT);
  const u16* ST = (const u16*)(ws + OFF_INCR);
  u16* RG = (u16*)(ws + OFF_RG);
  const int half = threadIdx.x >> 8;
  smem += half * 51200;
  const int tid = otid() & 255, lane = tid & 63, wave = tid >> 6;
  const int r = lane & 31, hh = lane >> 5;
  const float LOG2E = 1.4426950408889634f;
  for (int pi = blockIdx.x; pi < 4 * 64 * 4; pi += gridDim.x) {
    const int item = 2 * pi + half;
    const int h = item & 7, n = (item >> 3) & 63, b = item >> 9;
    const int row0 = b * SEQ + n * 128;
    const float lgf2 = -__expf(p.decay_f[h]) * LOG2E, lgb2 = -__expf(p.decay_b[h]) * LOG2E;
    const int qi = wave * 32 + r;
    bf16x8 qf[4];
#pragma unroll
    for (int s = 0; s < 4; ++s) qf[s] = *(const bf16x8*)(RQ + (size_t)(row0 + qi) * 512 + h * 64 + (2 * s + hh) * 8);
    __syncthreads();
    char* sF = smem;
    char* sB = smem + 16384;
    {
      const int lr = tid >> 3, lc = tid & 7;
      const u16* gf = ST + ((size_t)((0 * 4 + b) * 64 + n) * 8 + h) * 8192;
      const u16* gb = ST + ((size_t)((1 * 4 + b) * 64 + n) * 8 + h) * 8192;
#pragma unroll
      for (int q = 0; q < 4; ++q) {
        const int row = lr + 32 * q;
        const int so = row * 128 + ((lc ^ ((row >> 1) & 7)) << 4);
        *(u32x4*)(sF + so) = *(const u32x4*)(gf + row * 64 + lc * 8);
        *(u32x4*)(sB + so) = *(const u32x4*)(gb + row * 64 + lc * 8);
      }
    }
    __syncthreads();
    f32x16 O[4];
    {
      const float wq = __builtin_amdgcn_exp2f(lgf2 * (float)(qi + 1));
      const float wqb = __builtin_amdgcn_exp2f(lgb2 * (float)(128 - qi));
#pragma unroll
      for (int eb = 0; eb < 4; ++eb) {
        const int e = eb * 32 + r;
        f32x16 t;
        zero_acc(t);
#pragma unroll
        for (int s = 0; s < 4; ++s) {
          const bf16x8 a = *(const bf16x8*)(sF + e * 128 + (((2 * s + hh) ^ ((e >> 1) & 7)) << 4));
          t = MFMA32(a, qf[s], t);
        }
#pragma unroll
        for (int i = 0; i < 16; ++i) O[eb][i] = t[i] * wq;
        zero_acc(t);
#pragma unroll
        for (int s = 0; s < 4; ++s) {
          const bf16x8 a = *(const bf16x8*)(sB + e * 128 + (((2 * s + hh) ^ ((e >> 1) & 7)) << 4));
          t = MFMA32(a, qf[s], t);
        }
#pragma unroll
        for (int i = 0; i < 16; ++i) O[eb][i] += t[i] * wqb;
        __builtin_amdgcn_sched_barrier(0);
      }
    }
    __syncthreads();
    char* sK = smem;
    char* sV = smem + 16384;
    {
      const int lr = tid >> 3, lc = tid & 7;
#pragma unroll
      for (int q = 0; q < 4; ++q) {
        const int row = lr + 32 * q;
        *(u32x4*)(sK + row * 128 + ((lc ^ ((row >> 1) & 7)) << 4)) = *(const u32x4*)(RK + (size_t)(row0 + row) * 512 + h * 64 + lc * 8);
      }
      const int ve = tid & 127, vc0 = tid >> 7;
#pragma unroll
      for (int q = 0; q < 8; ++q) {
        const int c_ = vc0 + 2 * q;
        *(u32x4*)(sV + ve * 256 + ((c_ ^ (ve & 15)) << 4)) = *(const u32x4*)(RVT + ((size_t)((row0 >> 3) + c_) * 1024 + h * 128 + ve) * 8);
      }
    }
    __syncthreads();
    const int r_sw = (r & 0x13) | ((r & 4) << 1) | ((r & 8) >> 1);
#pragma unroll 1
    for (int kb = 0; kb < 4; ++kb) {
      f32x16 S;
      zero_acc(S);
      const int krow = kb * 32 + r_sw;
#pragma unroll
      for (int s = 0; s < 4; ++s) {
        const bf16x8 a = *(const bf16x8*)(sK + krow * 128 + (((2 * s + hh) ^ ((krow >> 1) & 7)) << 4));
        S = MFMA32(a, qf[s], S);
      }
      u32x4 pf[2];
#pragma unroll
      for (int t = 0; t < 2; ++t) {
        float pv[8];
#pragma unroll
        for (int jj = 0; jj < 8; ++jj) {
          const int key = kb * 32 + 16 * t + 8 * hh + jj;
          const int dlt = qi - key;
          const float w = __builtin_amdgcn_exp2f(dlt >= 0 ? lgf2 * (float)dlt : lgb2 * (float)(-dlt));
          pv[jj] = S[8 * t + jj] * w;
        }
        pf[t][0] = pack2(pv[0], pv[1]); pf[t][1] = pack2(pv[2], pv[3]);
        pf[t][2] = pack2(pv[4], pv[5]); pf[t][3] = pack2(pv[6], pv[7]);
      }
#pragma unroll
      for (int t = 0; t < 2; ++t) {
        const int ch = 2 * (2 * kb + t) + hh;
#pragma unroll
        for (int eb = 0; eb < 4; ++eb) {
          const int e = eb * 32 + r;
          const bf16x8 a = *(const bf16x8*)(sV + e * 256 + ((ch ^ (e & 15)) << 4));
          O[eb] = MFMA32(a, __builtin_bit_cast(bf16x8, pf[t]), O[eb]);
        }
        __builtin_amdgcn_sched_barrier(0);
      }
    }
    float sum = 0.f;
#pragma unroll
    for (int eb = 0; eb < 4; ++eb)
#pragma unroll
      for (int i = 0; i < 16; ++i) sum += O[eb][i];
    sum += __shfl_xor(sum, 32);
    const float mu = sum * (1.f / 128.f);
    float var = 0.f;
#pragma unroll
    for (int eb = 0; eb < 4; ++eb)
#pragma unroll
      for (int i = 0; i < 16; ++i) { const float d = O[eb][i] - mu; var += d * d; }
    var += __shfl_xor(var, 32);
    const float rstd = rsqrtf(var * (1.f / 128.f) + 1e-5f);
    u16* grow = RG + (size_t)(row0 + qi) * 1024 + h * 128;
#pragma unroll
    for (int eb = 0; eb < 4; ++eb)
#pragma unroll
      for (int g4 = 0; g4 < 4; ++g4) {
        u32x2* gp = (u32x2*)(grow + eb * 32 + 8 * g4 + 4 * hh);
        const u32x2 gv = *gp;
        const float y0 = (O[eb][4 * g4] - mu) * rstd * bflo(gv[0]);
        const float y1 = (O[eb][4 * g4 + 1] - mu) * rstd * bfhi(gv[0]);
        const float y2 = (O[eb][4 * g4 + 2] - mu) * rstd * bflo(gv[1]);
        const float y3 = (O[eb][4 * g4 + 3] - mu) * rstd * bfhi(gv[1]);
        u32x2 o = {pack2(y0, y1), pack2(y2, y3)};
        *gp = o;
        __builtin_amdgcn_sched_barrier(0);
      }
  }
}

DI void phase_mla_proj(const Params& p, char* smem) {
  char* ws = p.ws;
  const u16* KR = (const u16*)(ws + OFF_KR);
  u16* Q = (u16*)(ws + OFF_Q);
  u16* Kb = (u16*)(ws + OFF_K);
  u16* VT = (u16*)(ws + OFF_VT);
  u16* KM = (u16*)(ws + OFF_KM);
  u16* VM = (u16*)(ws + OFF_VM);
  const float2* TM = (const float2*)(ws + OFF_TMLA);
  const int tid = otid(), lane = tid & 63, wave = tid >> 6;
  const int wm = wave >> 1, wn = wave & 1, r = lane & 31, hh = lane >> 5;
  float* sRS = (float*)(smem + 133120);
  const float QSCALE = 0.10206207261596577f * 1.4426950408889634f;
  bool staged = false;
  for (int t = vbid(); t < 128 * 6; t += gridDim.x) {
    int mt, nt;
    tile_map(t, 128, 6, mt, nt);
    const int m0 = mt * 256, n0 = nt * 128;
    const u16 *nA = nullptr, *nB = nullptr;
    if (t + (int)gridDim.x < 128 * 6) {
      int mt2, nt2;
      tile_map(t + gridDim.x, 128, 6, mt2, nt2);
      nA = (const u16*)(ws + OFF_CQ) + (size_t)mt2 * 256 * 384; nB = (const u16*)(ws + OFF_WUQ) + (size_t)nt2 * 128 * 384;
    }
    RAW_BARRIER();
    if (tid < 256) {
      const float* ss = (const float*)(ws + OFF_SSQ) + (size_t)(m0 + tid) * 4;
      sRS[tid] = rsqrtf((ss[0] + ss[1] + ss[2]) * (1.f / 384.f) + 1e-6f) * QSCALE;
    }
    f32x16 acc[2][2];
#pragma unroll
    for (int mi = 0; mi < 2; ++mi)
#pragma unroll
      for (int ni = 0; ni < 2; ++ni) zero_acc(acc[mi][ni]);
    gemm_core<2>((const u16*)(ws + OFF_CQ) + (size_t)m0 * 384, 384, (const u16*)(ws + OFF_WUQ) + (size_t)n0 * 384, 384, 384, acc, smem, staged, nA, 384, nB, 384);
    staged = nA != nullptr;
    const int col0 = n0 + wn * 64;
    const int rl0 = wm * 64;
    if (col0 < 512) {
      u16* qbase = Q + (size_t)(m0 + rl0 + 4 * hh) * 768 + (col0 >> 6) * 96 + r;
#pragma unroll
      for (int mi = 0; mi < 2; ++mi)
#pragma unroll
        for (int i = 0; i < 16; ++i) {
          const int rlc = mi * 32 + (i & 3) + 8 * (i >> 2);
          const float rs = sRS[rl0 + 4 * hh + rlc];
          qbase[rlc * 768] = f2bf(acc[mi][0][i] * rs);
          qbase[rlc * 768 + 32] = f2bf(acc[mi][1][i] * rs);
        }
    } else {
      const int g = (col0 - 512) >> 6;
      const int head = 2 * g + (r >> 4), j = r & 15;
      u16* qbase = Q + (size_t)(m0 + rl0 + 4 * hh) * 768 + head * 96 + 64 + j;
#pragma unroll
      for (int mi = 0; mi < 2; ++mi)
#pragma unroll
        for (int i = 0; i < 16; ++i) {
          const int rlc = mi * 32 + (i & 3) + 8 * (i >> 2);
          const int rl = rl0 + 4 * hh + rlc;
          const float rs = sRS[rl];
          const float2 cs = TM[row_pos(m0 + rl) * 16 + j];
          const float x1 = acc[mi][0][i] * rs, x2 = acc[mi][1][i] * rs;
          qbase[rlc * 768] = f2bf(x1 * cs.x - x2 * cs.y);
          qbase[rlc * 768 + 16] = f2bf(x1 * cs.y + x2 * cs.x);
        }
    }
  }
  staged = false;
  for (int t = vbid(); t < 128 * 8; t += gridDim.x) {
    int mt, nt;
    tile_map(t, 128, 8, mt, nt);
    const int m0 = mt * 256, n0 = nt * 128;
    const u16 *nA = nullptr, *nB = nullptr;
    if (t + (int)gridDim.x < 128 * 8) {
      int mt2, nt2;
      tile_map(t + gridDim.x, 128, 8, mt2, nt2);
      nA = (const u16*)(ws + OFF_CKV) + (size_t)mt2 * 256 * 256; nB = (const u16*)(ws + OFF_WUKV) + (size_t)nt2 * 128 * 256;
    }
    RAW_BARRIER();
    if (tid < 256) {
      const float* ss = (const float*)(ws + OFF_SSKV) + (size_t)(m0 + tid) * 4;
      sRS[tid] = rsqrtf((ss[0] + ss[1]) * (1.f / 256.f) + 1e-6f);
    }
    f32x16 acc[2][2];
#pragma unroll
    for (int mi = 0; mi < 2; ++mi)
#pragma unroll
      for (int ni = 0; ni < 2; ++ni) zero_acc(acc[mi][ni]);
    gemm_core<2>((const u16*)(ws + OFF_CKV) + (size_t)m0 * 256, 256, (const u16*)(ws + OFF_WUKV) + (size_t)n0 * 256, 256, 256, acc, smem, staged, nA, 256, nB, 256);
    staged = nA != nullptr;
    const int col0 = n0 + wn * 64;
    const int rl0 = wm * 64;
    const int bb = m0 >> 13, key0 = m0 & (SEQ - 1);
    if (col0 < 512) {
      u16* kbase = Kb + ((size_t)(bb * 8 + (col0 >> 6)) * SEQ + key0 + rl0 + 4 * hh) * 96 + r;
#pragma unroll
      for (int mi = 0; mi < 2; ++mi)
#pragma unroll
        for (int i = 0; i < 16; ++i) {
          const int rlc = mi * 32 + (i & 3) + 8 * (i >> 2);
          const float rs = sRS[rl0 + 4 * hh + rlc];
          kbase[rlc * 96] = f2bf(acc[mi][0][i] * rs);
          kbase[rlc * 96 + 32] = f2bf(acc[mi][1][i] * rs);
        }
    } else {
      u16* vhead = VT + (size_t)(bb * 8 + ((col0 - 512) >> 6)) * 64 * SEQ;
#pragma unroll
      for (int mi = 0; mi < 2; ++mi) {
        const int rlm = rl0 + mi * 32;
        const float4 rsa = *(const float4*)(sRS + rlm + 4 * hh), rsb = *(const float4*)(sRS + rlm + 8 + 4 * hh);
        const float4 rsc = *(const float4*)(sRS + rlm + 16 + 4 * hh), rsd = *(const float4*)(sRS + rlm + 24 + 4 * hh);
        const float rsv[16] = {rsa.x, rsa.y, rsa.z, rsa.w, rsb.x, rsb.y, rsb.z, rsb.w, rsc.x, rsc.y, rsc.z, rsc.w, rsd.x, rsd.y, rsd.z, rsd.w};
#pragma unroll
        for (int ni = 0; ni < 2; ++ni) {
          float v[16];
#pragma unroll
          for (int i = 0; i < 16; ++i) v[i] = acc[mi][ni][i] * rsv[i];
          store_tokblk(vhead + ((size_t)((key0 + rlm) >> 3) * 64 + ni * 32 + r) * 8, 64, v, hh);
        }
      }
    }
  }
  {
    const int gtid = blockIdx.x * NTHR + tid, gthreads = gridDim.x * NTHR;
    const u16* CKV = (const u16*)(ws + OFF_CKV);
    const u16* WUKV = (const u16*)(ws + OFF_WUKV);
    const float* SSKV = (const float*)(ws + OFF_SSKV);
    for (int idx = gtid; idx < 64 * 1024; idx += gthreads) {
      const int row = idx >> 10, n = idx & 1023;
      float v = 0.f;
      if (row < 16) {
        const u32x4* a = (const u32x4*)(CKV + (size_t)(M + row) * 256);
        const u32x4* w = (const u32x4*)(WUKV + (size_t)n * 256);
        float acc = 0.f;
        for (int k = 0; k < 32; ++k) {
          const u32x4 av = a[k], wv = w[k];
#pragma unroll
          for (int j = 0; j < 4; ++j) acc += bflo(av[j]) * bflo(wv[j]) + bfhi(av[j]) * bfhi(wv[j]);
        }
        const float* ss = SSKV + (size_t)(M + row) * 4;
        v = acc * rsqrtf((ss[0] + ss[1]) * (1.f / 256.f) + 1e-6f);
      }
      if (n < 512) KM[(size_t)((n >> 6) * 64 + row) * 96 + (n & 63)] = f2bf(v);
      else VM[(size_t)((n - 512) >> 6) * 64 * 64 + ((size_t)(row >> 3) * 64 + ((n - 512) & 63)) * 8 + (row & 7)] = f2bf(v);
    }
  }
  {
    const int gtid = blockIdx.x * NTHR + tid, gthreads = gridDim.x * NTHR;
    const int total = (M + 64) * 8 * 4;
    for (int idx = gtid; idx < total; idx += gthreads) {
      const int c = idx & 3, head = (idx >> 2) & 7, row = idx >> 5;
      const u32x4 v = *(const u32x4*)(KR + (size_t)row * 32 + c * 8);
      if (row < M) {
        const int bb = row >> 13, key = row & (SEQ - 1);
        *(u32x4*)(Kb + ((size_t)(bb * 8 + head) * SEQ + key) * 96 + 64 + c * 8) = v;
      } else {
        *(u32x4*)(KM + (size_t)(head * 64 + (row - M)) * 96 + 64 + c * 8) = v;
      }
    }
  }
}

DI void phase_attn(const Params& p, char* smem) {
  char* ws = p.ws;
  const u16* Q = (const u16*)(ws + OFF_Q);
  const u16* Kb = (const u16*)(ws + OFF_K);
  const u16* VT = (const u16*)(ws + OFF_VT);
  const u16* KM = (const u16*)(ws + OFF_KM);
  const u16* VM = (const u16*)(ws + OFF_VM);
  u16* AO = (u16*)(ws + OFF_AO);
  char* sK0 = smem;
  char* sK1 = smem + 12288;
  char* sV0 = smem + 24576;
  char* sV1 = smem + 32768;
  const int tid = otid(), lane = tid & 63, wave = tid >> 6;
  const int r = lane & 31, hh = lane >> 5;
  const int r_sw = (r & 0x13) | ((r & 4) << 1) | ((r & 8) >> 1);
  const int kw0 = (tid / 12) * 192 + (((tid % 12) ^ (((tid / 12) >> 2) & 3)) << 4);
  const int ci1 = tid + 512;
  const int kw1 = (ci1 / 12) * 192 + (((ci1 % 12) ^ (((ci1 / 12) >> 2) & 3)) << 4);
  const int vw = (tid & 63) * 128 + (((tid >> 6) ^ (((tid & 63) >> 1) & 7)) << 4);
  const bool k2 = tid < 256;
  const int grp = __builtin_amdgcn_readfirstlane(wave) >> 2;
  const int kr0 = r_sw * 192, kr1 = (32 + r_sw) * 192, ksw = (r_sw >> 2) & 3;
  const int vr0 = r * 128, vr1 = (32 + r) * 128, vsw = (r >> 1) & 7;
  const u32x4 ones_u = {0x3F803F80u, 0x3F803F80u, 0x3F803F80u, 0x3F803F80u};
  const bf16x8 ones = __builtin_bit_cast(bf16x8, ones_u);
  for (int item = vbid(); item < 32 * 32; item += gridDim.x) {
    const int qb = item & 31, bh = item >> 5;
    const int b = bh >> 3, h = bh & 7;
    const int qrow = b * SEQ + qb * 256 + wave * 32 + r;
    bf16x8 qf[6];
#pragma unroll
    for (int s = 0; s < 6; ++s) qf[s] = *(const bf16x8*)(Q + (size_t)qrow * 768 + h * 96 + (2 * s + hh) * 8);
    const u16* Kg = Kb + (size_t)bh * SEQ * 96;
    const u16* Vg = VT + (size_t)bh * 64 * SEQ;
    const u16* Kmeta = KM + (size_t)h * 64 * 96;
    const u16* Vmeta = VM + (size_t)h * 64 * 64;
    f32x16 O[2], negm;
    zero_acc(O[0]); zero_acc(O[1]); zero_acc(negm);
    float mrun = 0.f, lrun = 0.f;
    u32x4 rk0, rk1, rv;
#define A_LOADK(T, RK0, RK1)                                                        \
  if ((T) <= 128) {                                                                 \
    const u16* ks_ = (T) == 128 ? Kmeta : Kg + (size_t)(T) * 64 * 96;               \
    RK0 = *(const u32x4*)(ks_ + (size_t)tid * 8);                                   \
    if (k2) RK1 = *(const u32x4*)(ks_ + (size_t)(tid + 512) * 8);                   \
  }
#define A_LOADV(T, RV)                                                              \
  if ((T) <= 128) {                                                                 \
    const u16* vs_ = (T) == 128 ? Vmeta : Vg + (size_t)(T) * 4096;                  \
    RV = *(const u32x4*)(vs_ + (size_t)tid * 8);                                    \
  }
#define A_WRITEK(DST, RK0, RK1) { *(u32x4*)((DST) + kw0) = RK0; if (k2) *(u32x4*)((DST) + kw1) = RK1; }
#define A_WRITEV(DST, RV) { *(u32x4*)((DST) + vw) = RV; }
#define A_QK(S, KB, MREF)                                                           \
  {                                                                                 \
    MREF = mrun;                                                                    \
    _Pragma("unroll") for (int s = 0; s < 6; ++s) {                                 \
      const int co_ = (((2 * s + hh) ^ ksw) << 4);                                  \
      const bf16x8 a0_ = *(const bf16x8*)((KB) + kr0 + co_);                        \
      const bf16x8 a1_ = *(const bf16x8*)((KB) + kr1 + co_);                        \
      if (s == 0) {                                                                 \
        S[0] = MFMA32(a0_, qf[s], negm);                                            \
        S[1] = MFMA32(a1_, qf[s], negm);                                            \
      } else {                                                                      \
        S[0] = MFMA32(a0_, qf[s], S[0]);                                            \
        S[1] = MFMA32(a1_, qf[s], S[1]);                                            \
      }                                                                             \
    }                                                                               \
  }
#define A_SOFTMAX_PV(S, VB, MASKED, MREF, FIRST)                                    \
  {                                                                                 \
    if (MASKED) {                                                                   \
      _Pragma("unroll") for (int i = 0; i < 16; ++i) { if (i >= 8) S[0][i] = -INFINITY; S[1][i] = -INFINITY; }  \
    }                                                                               \
    float mx_ = S[0][0];                                                            \
    _Pragma("unroll") for (int i = 1; i < 16; ++i) mx_ = fmaxf(mx_, S[0][i]);       \
    _Pragma("unroll") for (int i = 0; i < 16; ++i) mx_ = fmaxf(mx_, S[1][i]);       \
    mx_ = fmaxf(mx_, __shfl_xor(mx_, 32));                                          \
    const float d_ = MREF - mrun;                                                   \
    const float cand_ = mx_ + d_;                                                   \
    const bool upd_ = (FIRST) || cand_ > 8.f;                                       \
    if (__builtin_amdgcn_ballot_w64(upd_ || d_ != 0.f) != 0) {                      \
      const float mnew_ = upd_ ? mrun + cand_ : mrun;                               \
      const float shift_ = MREF - mnew_;                                            \
      const float alpha_ = (FIRST) ? 1.f : __builtin_amdgcn_exp2f(mrun - mnew_);    \
      mrun = mnew_;                                                                 \
      _Pragma("unroll") for (int i = 0; i < 16; ++i) {                              \
        O[0][i] *= alpha_; O[1][i] *= alpha_;                                       \
        S[0][i] += shift_; S[1][i] += shift_;                                       \
      }                                                                             \
      lrun *= alpha_;                                                               \
      _Pragma("unroll") for (int i = 0; i < 16; ++i) negm[i] = -mnew_;              \
    }                                                                               \
    _Pragma("unroll") for (int sp = 0; sp < 4; ++sp) {                              \
      const int mb = sp >> 1, t_ = sp & 1;                                          \
      u32x4 pf_;                                                                    \
      float e_[8];                                                                  \
      _Pragma("unroll") for (int q = 0; q < 8; ++q) { e_[q] = __builtin_amdgcn_exp2f(S[mb][8 * t_ + q]); lrun += e_[q]; }  \
      pf_[0] = pack2(e_[0], e_[1]); pf_[1] = pack2(e_[2], e_[3]);                   \
      pf_[2] = pack2(e_[4], e_[5]); pf_[3] = pack2(e_[6], e_[7]);                   \
      const int co_ = (((2 * sp + hh) ^ vsw) << 4);                                 \
      const bf16x8 v0_ = *(const bf16x8*)((VB) + vr0 + co_);                        \
      const bf16x8 v1_ = *(const bf16x8*)((VB) + vr1 + co_);                        \
      const bf16x8 pb_ = __builtin_bit_cast(bf16x8, pf_);                           \
      O[0] = MFMA32(v0_, pb_, O[0]);                                                \
      O[1] = MFMA32(v1_, pb_, O[1]);                                                \
    }                                                                               \
  }
#define A_STEP(J, SCUR, MCUR, SNEXT, MNEXT, KW, VW, KR, VR, RK0, RK1, RV)           \
  {                                                                                 \
    A_WRITEK(KW, RK0, RK1)                                                          \
    A_LOADK((J) + 3, RK0, RK1)                                                      \
    __builtin_amdgcn_sched_barrier(0);                                              \
    __builtin_amdgcn_s_setprio(1);                                                  \
    A_QK(SNEXT, KR, MNEXT)                                                          \
    __builtin_amdgcn_s_setprio(0);                                                  \
    RAW_BARRIER();                                                                  \
    A_WRITEV(VW, RV)                                                                \
    A_LOADV((J) + 2, RV)                                                            \
    __builtin_amdgcn_sched_barrier(0);                                              \
    A_SOFTMAX_PV(SCUR, VR, false, MCUR, (J) == 0)                                   \
    RAW_BARRIER();                                                                  \
  }
    __syncthreads();
    {
      u32x4 tk0, tk1;
      A_LOADK(0, rk0, rk1) A_LOADV(0, rv) A_LOADK(1, tk0, tk1)
      A_WRITEK(sK0, rk0, rk1) A_WRITEV(sV0, rv)
      A_LOADK(2, rk0, rk1) A_LOADV(1, rv)
      A_WRITEK(sK1, tk0, tk1)
    }
    __syncthreads();
    f32x16 SA[2], SB[2];
    float mrefA, mrefB;
    A_QK(SA, sK0, mrefA)
    RAW_BARRIER();
    if (grp == 1) __builtin_amdgcn_s_barrier();
    for (int j = 0; j < 128; j += 2) {
      A_STEP(j, SA, mrefA, SB, mrefB, sK0, sV1, sK1, sV0, rk0, rk1, rv)
      A_STEP(j + 1, SB, mrefB, SA, mrefA, sK1, sV0, sK0, sV1, rk0, rk1, rv)
    }
    RAW_BARRIER();
    A_SOFTMAX_PV(SA, sV0, true, mrefA, false)
    if (grp == 0) RAW_BARRIER();
#undef A_LOADK
#undef A_LOADV
#undef A_WRITEK
#undef A_WRITEV
#undef A_QK
#undef A_SOFTMAX_PV
#undef A_STEP
    lrun += __shfl_xor(lrun, 32);
    const float inv = 1.f / lrun;
    u16* dst = AO + (size_t)qrow * 512 + h * 64;
#pragma unroll
    for (int dvb = 0; dvb < 2; ++dvb)
#pragma unroll
      for (int g4 = 0; g4 < 4; ++g4) {
        u32x2 o = {pack2(O[dvb][4 * g4] * inv, O[dvb][4 * g4 + 1] * inv), pack2(O[dvb][4 * g4 + 2] * inv, O[dvb][4 * g4 + 3] * inv)};
        *(u32x2*)(dst + dvb * 32 + 8 * g4 + 4 * hh) = o;
      }
  }
}

DI void phase_merge(const Params& p, char* smem) {
  char* ws = p.ws;
  const u16* YR = (const u16*)(ws + OFF_RG);
  const u16* AO = (const u16*)(ws + OFF_AO);
  const u16* GRET = (const u16*)(ws + OFF_GRET);
  const u16* GMLA = (const u16*)(ws + OFF_GMLA);
  const u16* WRET = (const u16*)(ws + OFF_WRET);
  const u16* WMLA = (const u16*)(ws + OFF_WMLA);
  u16* MG = (u16*)(ws + OFF_MG);
  const int tid = otid(), lane = tid & 63, wave = tid >> 6;
  const int wm = wave >> 1, wn = wave & 1, r = lane & 31, hh = lane >> 5;
  bool staged = false;
  for (int t = vbid(); t < 128 * 8; t += gridDim.x) {
    int mt, nt;
    tile_map(t, 128, 8, mt, nt);
    const int m0 = mt * 256, n0 = nt * 128;
    const u16 *nA = nullptr, *nB = nullptr;
    if (t + (int)gridDim.x < 128 * 8) {
      int mt2, nt2;
      tile_map(t + gridDim.x, 128, 8, mt2, nt2);
      nA = YR + (size_t)mt2 * 256 * 1024; nB = WRET + (size_t)nt2 * 128 * 1024;
    }
    f32x16 a1[2][2], a2[2][2];
#pragma unroll
    for (int mi = 0; mi < 2; ++mi)
#pragma unroll
      for (int ni = 0; ni < 2; ++ni) { zero_acc(a1[mi][ni]); zero_acc(a2[mi][ni]); }
    gemm_core<2>(YR + (size_t)m0 * 1024, 1024, WRET + (size_t)n0 * 1024, 1024, 1024, a1, smem, staged,
                 AO + (size_t)m0 * 512, 512, WMLA + (size_t)n0 * 512, 512);
    gemm_core<2>(AO + (size_t)m0 * 512, 512, WMLA + (size_t)n0 * 512, 512, 512, a2, smem, true, nA, 1024, nB, 1024);
    staged = nA != nullptr;
    {
      const int R = (m0 + wm * 64) >> 6, C0 = (n0 + wn * 64) >> 5;
#pragma unroll
      for (int mi = 0; mi < 2; ++mi) {
#pragma unroll
        for (int ni = 0; ni < 2; ++ni) {
          const size_t go = ((((size_t)R * 32 + C0 + ni) * 2 + mi) * 64 + lane) * 16;
          const u32x4 g0 = *(const u32x4*)(GRET + go), g1 = *(const u32x4*)(GRET + go + 8);
          const u32x4 h0 = *(const u32x4*)(GMLA + go), h1 = *(const u32x4*)(GMLA + go + 8);
          u16* mrow = MG + (size_t)(m0 + wm * 64 + mi * 32 + 4 * hh) * 1024 + n0 + wn * 64 + ni * 32 + r;
#pragma unroll
          for (int i = 0; i < 16; ++i) {
            const unsigned gu = i < 8 ? g0[i >> 1] : g1[(i - 8) >> 1];
            const unsigned hu = i < 8 ? h0[i >> 1] : h1[(i - 8) >> 1];
            const float gr = (i & 1) ? bfhi(gu) : bflo(gu);
            const float gm = (i & 1) ? bfhi(hu) : bflo(hu);
            mrow[(size_t)((i & 3) + 8 * (i >> 2)) * 1024] = f2bf(gr * a1[mi][ni][i] + gm * a2[mi][ni][i]);
          }
        }
        __builtin_amdgcn_sched_barrier(0);
      }
    }
  }
}

DI void phase_wo(const Params& p, char* smem) {
  char* ws = p.ws;
  const u16* MG = (const u16*)(ws + OFF_MG);
  const u16* WO = (const u16*)(ws + OFF_WO);
  u16* H1B = (u16*)(ws + OFF_H1B);
  float* SS1 = (float*)(ws + OFF_SS1);
  const int tid = otid(), lane = tid & 63, wave = tid >> 6;
  const int wm = wave >> 1, wn = wave & 1, r = lane & 31, hh = lane >> 5;
  bool staged = false;
  for (int t = vbid(); t < 128 * 4; t += gridDim.x) {
    int mt, nt;
    tile_map(t, 128, 4, mt, nt);
    const int m0 = mt * 256, n0 = nt * 256;
    const u16 *nA = nullptr, *nB = nullptr;
    if (t + (int)gridDim.x < 128 * 4) {
      int mt2, nt2;
      tile_map(t + gridDim.x, 128, 4, mt2, nt2);
      nA = MG + (size_t)mt2 * 256 * 1024; nB = WO + (size_t)nt2 * 256 * 1024;
    }
    f32x16 acc[2][4];
#pragma unroll
    for (int mi = 0; mi < 2; ++mi)
#pragma unroll
      for (int ni = 0; ni < 4; ++ni) zero_acc(acc[mi][ni]);
    gemm8<false>(MG + (size_t)m0 * 1024, 1024, WO + (size_t)n0 * 1024, 1024, 1024, acc, smem);
    const int col0 = n0 + wn * 128;
#pragma unroll
    for (int mi = 0; mi < 2; ++mi) {
#pragma unroll
      for (int i = 0; i < 16; ++i) {
        const int row = m0 + wm * 64 + mi * 32 + crow(i, hh);
#pragma unroll
        for (int ni = 0; ni < 4; ++ni) {
          const size_t o = (size_t)row * 1024 + col0 + ni * 32 + r;
          const float v = p.x[o] + acc[mi][ni][i];
          acc[mi][ni][i] = v;
          H1B[o] = f2bf(v);
        }
      }
      __builtin_amdgcn_sched_barrier(0);
    }
    rowss_partial<4>(acc, smem, SS1, 8, col0 >> 7, m0, true);
  }
}

DI void phase_gu(const Params& p, char* smem) {
  char* ws = p.ws;
  const u16* H1B = (const u16*)(ws + OFF_H1B);
  const u16* WGU = (const u16*)(ws + OFF_WGU);
  const float* SS1 = (const float*)(ws + OFF_SS1);
  u16* ACT = (u16*)(ws + OFF_ACT);
  float* sRS = (float*)(smem + 133120);
  const int tid = otid(), lane = tid & 63, wave = tid >> 6;
  const int wm = wave >> 1, wn = wave & 1, r = lane & 31, hh = lane >> 5;
  constexpr int NT = 5632 / 256;
  bool staged = false;
  for (int t = vbid(); t < 128 * NT; t += gridDim.x) {
    int mt, nt;
    tile_map(t, 128, NT, mt, nt);
    const int m0 = mt * 256, n0 = nt * 256;
    const u16 *nA = nullptr, *nB = nullptr;
    if (t + (int)gridDim.x < 128 * NT) {
      int mt2, nt2;
      tile_map(t + gridDim.x, 128, NT, mt2, nt2);
      nA = H1B + (size_t)mt2 * 256 * 1024; nB = WGU + (size_t)nt2 * 256 * 1024;
    }
    RAW_BARRIER();
    if (tid < 256) {
      const float4 a = *(const float4*)(SS1 + (size_t)(m0 + tid) * 8), b = *(const float4*)(SS1 + (size_t)(m0 + tid) * 8 + 4);
      sRS[tid] = rsqrtf((a.x + a.y + a.z + a.w + b.x + b.y + b.z + b.w) * (1.f / 1024.f) + 1e-6f);
    }
    f32x16 acc[2][4];
#pragma unroll
    for (int mi = 0; mi < 2; ++mi)
#pragma unroll
      for (int ni = 0; ni < 4; ++ni) zero_acc(acc[mi][ni]);
    gemm8<true>(H1B + (size_t)m0 * 1024, 1024, WGU + (size_t)n0 * 1024, 1024, 1024, acc, smem);
    const int col0 = n0 + wn * 128;
#pragma unroll
    for (int mi = 0; mi < 2; ++mi) {
      const int rl = wm * 64 + mi * 32 + r;
      const float rs = sRS[rl];
      u16* arow = ACT + (size_t)(m0 + rl) * DFF + (col0 >> 1);
#pragma unroll
      for (int gi = 0; gi < 2; ++gi) {
        float v[16];
#pragma unroll
        for (int i = 0; i < 16; ++i) v[i] = siluf_(acc[mi][2 * gi][i] * rs) * (acc[mi][2 * gi + 1][i] * rs);
        store_block32(arow + gi * 32, v, hh);
      }
    }
  }
}

DI void phase_down(const Params& p, char* smem) {
  char* ws = p.ws;
  const u16* ACT = (const u16*)(ws + OFF_ACT);
  const u16* WD = (const u16*)(ws + OFF_WD);
  const u16* H1B = (const u16*)(ws + OFF_H1B);
  const int tid = otid(), lane = tid & 63, wave = tid >> 6;
  const int wm = wave >> 1, wn = wave & 1, r = lane & 31, hh = lane >> 5;
  bool staged = false;
  for (int t = vbid(); t < 128 * 4; t += gridDim.x) {
    int mt, nt;
    tile_map(t, 128, 4, mt, nt);
    const int m0 = mt * 256, n0 = nt * 256;
    const u16 *nA = nullptr, *nB = nullptr;
    if (t + (int)gridDim.x < 128 * 4) {
      int mt2, nt2;
      tile_map(t + gridDim.x, 128, 4, mt2, nt2);
      nA = ACT + (size_t)mt2 * 256 * DFF; nB = WD + (size_t)nt2 * 256 * DFF;
    }
    f32x16 acc[2][4];
#pragma unroll
    for (int mi = 0; mi < 2; ++mi)
#pragma unroll
      for (int ni = 0; ni < 4; ++ni) zero_acc(acc[mi][ni]);
    gemm8<false>(ACT + (size_t)m0 * DFF, DFF, WD + (size_t)n0 * DFF, DFF, DFF, acc, smem);
    const int col0 = n0 + wn * 128;
#pragma unroll
    for (int mi = 0; mi < 2; ++mi) {
#pragma unroll
      for (int i = 0; i < 16; ++i) {
        const int row = m0 + wm * 64 + mi * 32 + crow(i, hh);
#pragma unroll
        for (int ni = 0; ni < 4; ++ni) {
          const size_t o = (size_t)row * 1024 + col0 + ni * 32 + r;
          p.out[o] = bf2f(H1B[o]) + acc[mi][ni][i];
        }
      }
      __builtin_amdgcn_sched_barrier(0);
    }
  }
}

DI void phase_final(const Params& p) {
  const int gtid = blockIdx.x * NTHR + threadIdx.x, gthreads = gridDim.x * NTHR;
  const int lane = threadIdx.x & 63;
  const int gwave = gtid >> 6, nwaves = gthreads >> 6;
  float4 w[4];
#pragma unroll
  for (int q = 0; q < 4; ++q) w[q] = *(const float4*)(p.norm_final_w + q * 256 + lane * 4);
  for (int row0 = gwave * 4; row0 < M; row0 += nwaves * 4) {
    float4 v[4][4];
#pragma unroll
    for (int k = 0; k < 4; ++k)
#pragma unroll
      for (int q = 0; q < 4; ++q) v[k][q] = *(const float4*)(p.out + (size_t)(row0 + k) * 1024 + q * 256 + lane * 4);
#pragma unroll
    for (int k = 0; k < 4; ++k) {
      float ss = 0.f;
#pragma unroll
      for (int q = 0; q < 4; ++q) ss += v[k][q].x * v[k][q].x + v[k][q].y * v[k][q].y + v[k][q].z * v[k][q].z + v[k][q].w * v[k][q].w;
      ss = wave_sum(ss);
      const float rs = rsqrtf(ss * (1.f / 1024.f) + 1e-6f);
#pragma unroll
      for (int q = 0; q < 4; ++q) {
        float4 o = make_float4(v[k][q].x * rs * w[q].x, v[k][q].y * rs * w[q].y, v[k][q].z * rs * w[q].z, v[k][q].w * rs * w[q].w);
        *(float4*)(p.out + (size_t)(row0 + k) * 1024 + q * 256 + lane * 4) = o;
      }
    }
  }
}

#define XB_TMO      128
#define XB_XCNT(j)  (256  + 64 * (j))
#define XB_XSUB(j)  (1280 + 64 * (j))
#define XB_XGEN(j)  (2304 + 64 * (j))
#define XB_TOP      3328
#define XB_TOPGEN   3392
#define XCD_BAR_WORDS 3456
#define XB_SPIN_CAP (1u << 18)
#define LAS __attribute__((address_space(3)))

DI unsigned xb_ld(unsigned* p)              { return __hip_atomic_load(p, __ATOMIC_RELAXED, __HIP_MEMORY_SCOPE_AGENT); }
DI unsigned xb_add(unsigned* p, unsigned v) { return __hip_atomic_fetch_add(p, v, __ATOMIC_RELAXED, __HIP_MEMORY_SCOPE_AGENT); }
DI unsigned xb_xcc_id() { return (unsigned)__builtin_amdgcn_s_getreg((3 << 11) | 20) & 0xFu; }
#define XB_SPIN(cond, bar) do { unsigned _sp = 0; while (cond) { __builtin_amdgcn_s_sleep(1); \
    if ((++_sp & 255u) == 0u) { if (xb_ld(&(bar)[XB_TMO])) break; if (_sp > XB_SPIN_CAP) { atomicAdd(&(bar)[XB_TMO], 1u); break; } } } } while (0)

struct XcdBarrier {
    unsigned* bar; unsigned x;
    volatile LAS unsigned* st;
};

DI XcdBarrier xcd_barrier_post(unsigned* bar, volatile LAS unsigned* st) {
    XcdBarrier b; b.bar = bar; b.x = xb_xcc_id(); b.st = st;
    if (threadIdx.x == 0) (void)xb_add(&bar[XB_XCNT(b.x)], 1u);
    return b;
}
DI void xcd_barrier_complete(unsigned* bar, unsigned x, unsigned& nloc, unsigned& nx) {
    const unsigned G = gridDim.x * gridDim.y * gridDim.z;
    unsigned sum, cnt, mine, sp = 0u;
    for (;;) {
        sum = 0u; cnt = 0u; mine = 0u;
#pragma unroll
        for (unsigned j = 0; j < 16; ++j) { const unsigned c = xb_ld(&bar[XB_XCNT(j)]); sum += c; cnt += (c > 0u) ? 1u : 0u; mine = (j == x) ? c : mine; }
        if (sum == G) break;
        __builtin_amdgcn_s_sleep(1);
        if ((++sp & 255u) == 0u) { if (xb_ld(&bar[XB_TMO])) break; if (sp > XB_SPIN_CAP) { atomicAdd(&bar[XB_TMO], 1u); break; } }
    }
    nloc = mine > 0u ? mine : 1u; nx = cnt > 0u ? cnt : 1u;
}

DI void xcd_barrier(const XcdBarrier& b) {
    asm volatile("s_waitcnt vmcnt(0)" ::: "memory");
    __syncthreads();
    if (threadIdx.x == 0) {
        unsigned* bar = b.bar;
        __builtin_amdgcn_s_waitcnt(0);
        unsigned nloc = b.st[0], nx = b.st[1];
        if (nloc == 0u) { xcd_barrier_complete(bar, b.x, nloc, nx); b.st[0] = nloc; b.st[1] = nx; }
        const unsigned old = xb_add(&bar[XB_XSUB(b.x)], 1u);
        const unsigned gen = old / nloc;
        if (old + 1u == (gen + 1u) * nloc) {
            __builtin_amdgcn_fence(__ATOMIC_RELEASE, "agent");
            asm volatile("s_waitcnt vmcnt(0)" ::: "memory");
            const unsigned og = xb_add(&bar[XB_TOP], 1u);
            const unsigned tg = og / nx;
            if (og + 1u == (tg + 1u) * nx) xb_add(&bar[XB_TOPGEN], 1u);
            else XB_SPIN(xb_ld(&bar[XB_TOPGEN]) == tg, bar);
            __builtin_amdgcn_fence(__ATOMIC_ACQUIRE, "agent");
            xb_add(&bar[XB_XGEN(b.x)], 1u);
            asm volatile("s_waitcnt vmcnt(0)" ::: "memory");
        } else {
            XB_SPIN(xb_ld(&bar[XB_XGEN(b.x)]) == gen, bar);
            __builtin_amdgcn_fence(__ATOMIC_ACQUIRE, "agent");
            asm volatile("s_waitcnt vmcnt(0)" ::: "memory");
        }
    }
    __syncthreads();
}

DI void grid_barrier(unsigned* ctr, unsigned target) {
  asm volatile("s_waitcnt vmcnt(0)" ::: "memory");
  __syncthreads();
  if (threadIdx.x == 0) {
    __builtin_amdgcn_fence(__ATOMIC_RELEASE, "agent");
    asm volatile("s_waitcnt vmcnt(0)" ::: "memory");
    __hip_atomic_fetch_add(ctr, 1u, __ATOMIC_RELAXED, __HIP_MEMORY_SCOPE_AGENT);
    while (__hip_atomic_load(ctr, __ATOMIC_RELAXED, __HIP_MEMORY_SCOPE_AGENT) < target) __builtin_amdgcn_s_sleep(2);
    __builtin_amdgcn_fence(__ATOMIC_ACQUIRE, "agent");
    asm volatile("s_waitcnt vmcnt(0)" ::: "memory");
  }
  __syncthreads();
}

constexpr int NPHASE = 12;

#if MULTI_LAUNCH
#define PH_ARGS , int ph_lo, int ph_hi
#define RUN_PHASE(k, call) if (ph_lo <= (k) && (k) < ph_hi) { call; }
#else
#define PH_ARGS
#define RUN_PHASE(k, call) { call; if ((k) + 1 < NPHASE) { XcdBarrier b_; b_.bar = (unsigned*)(p.ws + OFF_BAR); b_.x = xb_xcc_id(); b_.st = (volatile LAS unsigned*)&xb_words; xcd_barrier(b_); } }
#endif

__global__ void __launch_bounds__(512, 2) mega(Params p PH_ARGS) {
  __shared__ __attribute__((aligned(16))) char smem[134144];
  __shared__ uint4 xb_words;
  if (threadIdx.x == 0) xb_words = make_uint4(0u, 0u, 0u, 0u);
  __syncthreads();
  if (p.ws == nullptr) cg::this_grid().sync();
  (void)xcd_barrier_post((unsigned*)(p.ws + OFF_BAR), (volatile LAS unsigned*)&xb_words);
  RUN_PHASE(0, phase_prep(p, smem))
  RUN_PHASE(1, phase_proj(p, smem))
  RUN_PHASE(2, phase_ret_incr(p, smem))
  RUN_PHASE(3, phase_ret_scan(p))
  RUN_PHASE(4, phase_ret_out(p, smem))
  RUN_PHASE(5, phase_mla_proj(p, smem))
  RUN_PHASE(6, phase_attn(p, smem))
  RUN_PHASE(7, phase_merge(p, smem))
  RUN_PHASE(8, phase_wo(p, smem))
  RUN_PHASE(9, phase_gu(p, smem))
  RUN_PHASE(10, phase_down(p, smem))
  RUN_PHASE(11, phase_final(p))
}

extern "C" void kernel_launch(void* const* d_in, const int* in_sizes, int n_in, void* d_out, int out_size,
                              void* d_ws, size_t ws_size, hipStream_t stream) {
  static int grid_blocks = 0;
  if (!grid_blocks) {
    int dev = 0, cus = 0, per_cu = 0;
    hipGetDevice(&dev);
    hipDeviceGetAttribute(&cus, hipDeviceAttributeMultiprocessorCount, dev);
    hipOccupancyMaxActiveBlocksPerMultiprocessor(&per_cu, mega, NTHR, 0);
    if (per_cu > 1) per_cu = 1;
    if (per_cu < 1) per_cu = 1;
    grid_blocks = cus * per_cu;
  }
  Params p{};
  p.x = (const float*)d_in[0]; p.meta = (const float*)d_in[1]; p.norm_mix_w = (const float*)d_in[2];
  p.w_in = (const float*)d_in[3]; p.decay_f = (const float*)d_in[4]; p.decay_b = (const float*)d_in[5];
  p.gn_w = (const float*)d_in[6]; p.w_ret_out = (const float*)d_in[7]; p.q_norm_w = (const float*)d_in[8];
  p.w_uq = (const float*)d_in[9]; p.kv_norm_w = (const float*)d_in[10]; p.w_uk = (const float*)d_in[11];
  p.w_uv = (const float*)d_in[12]; p.w_mla_out = (const float*)d_in[13]; p.w_o = (const float*)d_in[14];
  p.norm_ffn_w = (const float*)d_in[15]; p.w_gate = (const float*)d_in[16]; p.w_up = (const float*)d_in[17];
  p.w_down = (const float*)d_in[18]; p.norm_final_w = (const float*)d_in[19];
  p.out = (float*)d_out;
  p.ws = (char*)d_ws;
  if (ws_size < WS_END) { fprintf(stderr, "workspace too small: %zu < %zu\n", ws_size, (size_t)WS_END); return; }
#if MULTI_LAUNCH
  for (int ph = 0; ph < NPHASE; ++ph) hipLaunchKernelGGL(mega, dim3(grid_blocks), dim3(NTHR), 0, stream, p, ph, ph + 1);
#else
  hipMemsetAsync((char*)d_ws + OFF_BAR, 0, 16384, stream);
  void* args[] = {&p};
  hipError_t e = hipLaunchCooperativeKernel((void*)mega, dim3(grid_blocks), dim3(NTHR), args, 0, stream);
  if (e != hipSuccess) fprintf(stderr, "cooperative launch failed: %s (grid %d)\n", hipGetErrorString(e), grid_blocks);
#endif
}
```

```cpp
#include <hip/hip_runtime.h>
#include <hip/hip_cooperative_groups.h>
#include <stdint.h>
#include <cstdio>
namespace cg = cooperative_groups;

#ifndef MULTI_LAUNCH
#define MULTI_LAUNCH 0
#endif

typedef unsigned short u16;
typedef __attribute__((ext_vector_type(8))) short bf16x8;
typedef __attribute__((ext_vector_type(16))) float f32x16;
typedef __attribute__((ext_vector_type(4))) unsigned u32x4;
typedef __attribute__((ext_vector_type(2))) unsigned u32x2;
typedef __attribute__((ext_vector_type(2))) float f32x2;
typedef __attribute__((ext_vector_type(2))) __bf16 bf16x2v;

#define DI __device__ __forceinline__
#define MFMA32(a, b, c) __builtin_amdgcn_mfma_f32_32x32x16_bf16((a), (b), (c), 0, 0, 0)

constexpr int M = 32768;
constexpr int MT = 33024;
constexpr int NTHR = 512;
constexpr int SEQ = 8192;
constexpr int NPOS = 8208;
constexpr int DFF = 2816;
constexpr int NIN = 5888;

constexpr size_t SZ_WIN = (size_t)NIN * 1024 * 2;
constexpr size_t OFF_WIN = 0;
constexpr size_t OFF_WRET = OFF_WIN + SZ_WIN;
constexpr size_t OFF_WUQ = OFF_WRET + 1024 * 1024 * 2;
constexpr size_t OFF_WUKV = OFF_WUQ + 768 * 384 * 2;
constexpr size_t OFF_WMLA = OFF_WUKV + 1024 * 256 * 2;
constexpr size_t OFF_WO = OFF_WMLA + 1024 * 512 * 2;
constexpr size_t OFF_WGU = OFF_WO + 1024 * 1024 * 2;
constexpr size_t OFF_WD = OFF_WGU + (size_t)5632 * 1024 * 2;
constexpr size_t OFF_TRET = OFF_WD + (size_t)1024 * DFF * 2;
constexpr size_t OFF_TMLA = OFF_TRET + (size_t)NPOS * 32 * 8;
constexpr size_t OFF_R1 = OFF_TMLA + (size_t)NPOS * 16 * 8;
constexpr size_t SZ_U = (size_t)MT * 1024 * 2;
constexpr size_t OFF_RQ = OFF_R1 + SZ_U;
constexpr size_t OFF_RK = OFF_RQ + (size_t)M * 512 * 2;
constexpr size_t OFF_RKT = OFF_RK + (size_t)M * 512 * 2;
constexpr size_t OFF_RVT = OFF_RKT + (size_t)512 * MT * 2;
constexpr size_t OFF_RG = OFF_RVT + (size_t)1024 * MT * 2;
constexpr size_t OFF_CQ = OFF_RG + (size_t)M * 1024 * 2;
constexpr size_t OFF_CKV = OFF_CQ + (size_t)MT * 384 * 2;
constexpr size_t OFF_KR = OFF_CKV + (size_t)MT * 256 * 2;
constexpr size_t OFF_SSQ = OFF_KR + (size_t)MT * 32 * 2;
constexpr size_t OFF_SSKV = OFF_SSQ + (size_t)MT * 4 * 4;
constexpr size_t OFF_GRET = OFF_SSKV + (size_t)MT * 4 * 4;
constexpr size_t OFF_GMLA = OFF_GRET + (size_t)M * 1024 * 2;
constexpr size_t OFF_BAR = OFF_GMLA + (size_t)M * 1024 * 2;
constexpr size_t WS_END = OFF_BAR + 16384;
constexpr size_t OFF_INCR = OFF_R1;
constexpr size_t OFF_Q = OFF_R1;
constexpr size_t OFF_K = OFF_Q + (size_t)M * 768 * 2;
constexpr size_t OFF_VT = OFF_K + (size_t)32 * SEQ * 96 * 2;
constexpr size_t OFF_KM = OFF_VT + (size_t)32 * 64 * SEQ * 2;
constexpr size_t OFF_VM = OFF_KM + (size_t)8 * 64 * 96 * 2;
constexpr size_t OFF_AO = OFF_VM + (size_t)8 * 64 * 64 * 2;
constexpr size_t OFF_MG = OFF_R1;
constexpr size_t OFF_H1B = OFF_RG;
constexpr size_t OFF_SS1 = OFF_CQ;
constexpr size_t OFF_ACT = OFF_R1;
static_assert(OFF_AO + (size_t)M * 512 * 2 <= OFF_RG, "alias overflow");
static_assert(OFF_ACT + (size_t)M * DFF * 2 <= OFF_RG, "alias overflow");

struct Params {
  const float *x, *meta, *norm_mix_w, *w_in, *decay_f, *decay_b, *gn_w, *w_ret_out, *q_norm_w, *w_uq,
      *kv_norm_w, *w_uk, *w_uv, *w_mla_out, *w_o, *norm_ffn_w, *w_gate, *w_up, *w_down, *norm_final_w;
  float* out;
  char* ws;
};

DI unsigned pack2(float a, float b) {
  f32x2 v = {a, b};
  return __builtin_bit_cast(unsigned, __builtin_convertvector(v, bf16x2v));
}
DI u16 f2bf(float a) { return (u16)(pack2(a, 0.f) & 0xffffu); }
DI float bflo(unsigned u) { return __uint_as_float(u << 16); }
DI float bfhi(unsigned u) { return __uint_as_float(u & 0xffff0000u); }
DI float bf2f(u16 v) { return __uint_as_float(((unsigned)v) << 16); }
DI int otid() { int t = threadIdx.x; asm volatile("" : "+v"(t)); return t; }
DI int crow(int i, int hh) { return (i & 3) + 8 * (i >> 2) + 4 * hh; }
DI float sigmoidf_(float x) { return __builtin_amdgcn_rcpf(1.f + __builtin_amdgcn_exp2f(x * -1.4426950408889634f)); }
DI float siluf_(float x) { return x * __builtin_amdgcn_rcpf(1.f + __builtin_amdgcn_exp2f(x * -1.4426950408889634f)); }
DI float wave_sum(float v) {
#pragma unroll
  for (int o = 32; o > 0; o >>= 1) v += __shfl_xor(v, o);
  return v;
}
DI int row_pos(int row) {
  int p = row < M ? (row & (SEQ - 1)) + 16 : row - M;
  return p < NPOS ? p : NPOS - 1;
}
typedef __attribute__((ext_vector_type(2))) unsigned u32x2s;
DI void store_block32(u16* rowptr, const float (&v)[16], int hh) {
  unsigned a0 = pack2(v[0], v[1]), a1 = pack2(v[2], v[3]);
  unsigned b0 = pack2(v[4], v[5]), b1 = pack2(v[6], v[7]);
  unsigned c0 = pack2(v[8], v[9]), c1 = pack2(v[10], v[11]);
  unsigned d0 = pack2(v[12], v[13]), d1 = pack2(v[14], v[15]);
  u32x2s t;
  t = __builtin_amdgcn_permlane32_swap(a0, b0, false, false); a0 = t[0]; b0 = t[1];
  t = __builtin_amdgcn_permlane32_swap(a1, b1, false, false); a1 = t[0]; b1 = t[1];
  t = __builtin_amdgcn_permlane32_swap(c0, d0, false, false); c0 = t[0]; d0 = t[1];
  t = __builtin_amdgcn_permlane32_swap(c1, d1, false, false); c1 = t[0]; d1 = t[1];
  u32x4 lo = {a0, a1, b0, b1}, hi = {c0, c1, d0, d1};
  *(u32x4*)(rowptr + 8 * hh) = lo;
  *(u32x4*)(rowptr + 16 + 8 * hh) = hi;
}
DI void store_tokblk(u16* base, int fstride, const float (&v)[16], int hh) {
  unsigned a0 = pack2(v[0], v[1]), a1 = pack2(v[2], v[3]);
  unsigned b0 = pack2(v[4], v[5]), b1 = pack2(v[6], v[7]);
  unsigned c0 = pack2(v[8], v[9]), c1 = pack2(v[10], v[11]);
  unsigned d0 = pack2(v[12], v[13]), d1 = pack2(v[14], v[15]);
  u32x2s t;
  t = __builtin_amdgcn_permlane32_swap(a0, b0, false, false); a0 = t[0]; b0 = t[1];
  t = __builtin_amdgcn_permlane32_swap(a1, b1, false, false); a1 = t[0]; b1 = t[1];
  t = __builtin_amdgcn_permlane32_swap(c0, d0, false, false); c0 = t[0]; d0 = t[1];
  t = __builtin_amdgcn_permlane32_swap(c1, d1, false, false); c1 = t[0]; d1 = t[1];
  u32x4 lo = {a0, a1, b0, b1}, hi = {c0, c1, d0, d1};
  *(u32x4*)(base + (size_t)hh * fstride * 8) = lo;
  *(u32x4*)(base + (size_t)(2 + hh) * fstride * 8) = hi;
}
DI void zero_acc(f32x16& a) {
#pragma unroll
  for (int i = 0; i < 16; ++i) a[i] = 0.f;
}

DI int vbid() {
  const int G = gridDim.x;
  return (G & 7) ? (int)blockIdx.x : (int)(blockIdx.x & 7) * (G >> 3) + (int)(blockIdx.x >> 3);
}
DI bool tile_map(int seq, int mtiles, int NT, int& mt, int& nt) {
  const int panel = seq / (4 * NT), rem = seq - panel * 4 * NT;
  nt = rem >> 2;
  mt = panel * 4 + (rem & 3);
  return mt < mtiles;
}

typedef __attribute__((address_space(3))) void lds_void;
typedef const __attribute__((address_space(1))) void glb_void;
#define GLDS16(SRC, DST) __builtin_amdgcn_global_load_lds((glb_void*)(SRC), (lds_void*)(DST), 16, 0, 0)
#define WAIT_VM0() asm volatile("s_waitcnt vmcnt(0)" ::: "memory")
#define RAW_BARRIER() do { asm volatile("s_waitcnt lgkmcnt(0)" ::: "memory"); __builtin_amdgcn_s_barrier(); } while (0)
template <int NI, bool TR = false>
DI void gemm_core(const u16* __restrict__ A, int lda, const u16* __restrict__ Bt, int ldb, int K,
                  f32x16 (&acc)[2][NI], char* smem, bool staged = false, const u16* nA = nullptr, int nlda = 0,
                  const u16* nBt = nullptr, int nldb = 0) {
  constexpr int AB = 256 * 128;
  constexpr int BUF = AB + 64 * NI * 128;
  const int tid = otid(), lane = tid & 63, wave = tid >> 6;
  const int wm = wave >> 1, wn = wave & 1;
  const int r = lane & 31, hh = lane >> 5;
  const int lrow = tid >> 3, lc = tid & 7;
  const int rsw = (r >> 1) & 7;
  const u16* Ap = A + (size_t)lrow * lda + ((lc ^ ((lrow >> 1) & 7)) << 3);
  const u16* Bp = Bt + (size_t)lrow * ldb + ((lc ^ ((lrow >> 1) & 7)) << 3);
  char* lbase = smem + (wave << 10);
  const int nk = K >> 6;
  const int aoff = (wm * 64 + r) * 128, boff = AB + (wn * 32 * NI + r) * 128;
#define G_STAGE(ST, KT)                                                                             \
  {                                                                                                 \
    const int ko_ = (KT) * 64;                                                                      \
    char* d_ = lbase + (ST) * BUF;                                                                  \
    _Pragma("unroll") for (int p = 0; p < 4; ++p) GLDS16(Ap + (size_t)(64 * p) * lda + ko_, d_ + p * 8192);         \
    _Pragma("unroll") for (int p = 0; p < NI; ++p) GLDS16(Bp + (size_t)(64 * p) * ldb + ko_, d_ + AB + p * 8192);   \
  }
#define G_READ(FA, FB, S)                                                                           \
  {                                                                                                 \
    const int co_ = (((2 * (S) + hh) ^ rsw) << 4);                                                  \
    _Pragma("unroll") for (int mi = 0; mi < 2; ++mi) FA[mi] = *(const bf16x8*)(cur + aoff + mi * 4096 + co_);   \
    _Pragma("unroll") for (int ni = 0; ni < NI; ++ni) FB[ni] = *(const bf16x8*)(cur + boff + ni * 4096 + co_);  \
  }
#define G_MMA(FA, FB)                                                                               \
  {                                                                                                 \
    _Pragma("unroll") for (int mi = 0; mi < 2; ++mi)                                                \
      _Pragma("unroll") for (int ni = 0; ni < NI; ++ni)                                             \
        acc[mi][ni] = TR ? MFMA32(FB[ni], FA[mi], acc[mi][ni]) : MFMA32(FA[mi], FB[ni], acc[mi][ni]);           \
  }
  if (!staged) {
    __syncthreads();
    G_STAGE(0, 0)
  }
  WAIT_VM0();
  __syncthreads();
  for (int kt = 0; kt < nk; ++kt) {
    const char* cur = smem + (kt & 1) * BUF;
    bf16x8 fa0[2], fb0[NI], fa1[2], fb1[NI];
    if (kt + 1 < nk) G_STAGE((kt + 1) & 1, kt + 1)
    else if (nA) {
      const u16* nAp = nA + (size_t)lrow * nlda + ((lc ^ ((lrow >> 1) & 7)) << 3);
      const u16* nBp = nBt + (size_t)lrow * nldb + ((lc ^ ((lrow >> 1) & 7)) << 3);
      _Pragma("unroll") for (int p = 0; p < 4; ++p) GLDS16(nAp + (size_t)(64 * p) * nlda, lbase + p * 8192);
      _Pragma("unroll") for (int p = 0; p < NI; ++p) GLDS16(nBp + (size_t)(64 * p) * nldb, lbase + AB + p * 8192);
    }
    G_READ(fa0, fb0, 0)
    __builtin_amdgcn_sched_barrier(0);
    G_READ(fa1, fb1, 1)
    G_MMA(fa0, fb0)
    __builtin_amdgcn_sched_barrier(0);
    G_READ(fa0, fb0, 2)
    G_MMA(fa1, fb1)
    __builtin_amdgcn_sched_barrier(0);
    G_READ(fa1, fb1, 3)
    G_MMA(fa0, fb0)
    __builtin_amdgcn_sched_barrier(0);
    G_MMA(fa1, fb1)
    __builtin_amdgcn_sched_barrier(0);
    if (kt + 1 < nk) {
      WAIT_VM0();
      __syncthreads();
    } else {
      asm volatile("s_waitcnt lgkmcnt(0)" ::: "memory");
      __builtin_amdgcn_s_barrier();
    }
  }
#undef G_STAGE
#undef G_READ
#undef G_MMA
}

#define WAIT_V8(n) asm volatile("s_waitcnt vmcnt(" #n ")" ::: "memory")
#define WAIT_L8(n) asm volatile("s_waitcnt lgkmcnt(" #n ")" ::: "memory")
#define BAR8 __builtin_amdgcn_s_barrier()
#define SCHED8 __builtin_amdgcn_sched_barrier(0)
template <bool TR>
DI void gemm8(const u16* __restrict__ A, int lda, const u16* __restrict__ Bt, int ldb, int K,
              f32x16 (&acc)[2][4], char* smem) {
  const int tid = otid(), lane = tid & 63, wave = tid >> 6;
  const int r = lane & 31, hh = lane >> 5;
  const int grp = __builtin_amdgcn_readfirstlane(wave) >> 2;
  const int ir0 = wave * 8 + (lane >> 3), ir1 = ir0 + 64;
  const int csrc = ((lane & 7) ^ ((ir0 >> 1) & 7)) << 3;
  const unsigned vA0 = (unsigned)(((ir0 >> 5) * 64 + (ir0 & 31)) * lda + csrc) * 2u;
  const unsigned vA1 = (unsigned)(((ir1 >> 5) * 64 + (ir1 & 31)) * lda + csrc) * 2u;
  const unsigned vB0 = (unsigned)(((ir0 >> 6) * 128 + (ir0 & 63)) * ldb + csrc) * 2u;
  const unsigned vB1 = (unsigned)(((ir1 >> 6) * 128 + (ir1 & 63)) * ldb + csrc) * 2u;
  const int rsw = (r >> 1) & 7;
  typedef const __attribute__((address_space(3))) bf16x8 lds_frag;
  const unsigned sbase = (unsigned)(size_t)(lds_void*)smem;
  const unsigned lb = __builtin_amdgcn_readfirstlane(sbase + (wave << 10));
  unsigned aad[4], bad[4];
#pragma unroll
  for (int s = 0; s < 4; ++s) {
    aad[s] = sbase + ((wave >> 1) * 32 + r) * 128 + (((2 * s + hh) ^ rsw) << 4);
    bad[s] = sbase + 65536 + ((wave & 1) * 64 + r) * 128 + (((2 * s + hh) ^ rsw) << 4);
  }
#define SA8(b, h) (((b) * 2 + (h)) * 16384)
#define SB8(b, h) ((4 + (b) * 2 + (h)) * 16384)
#define STAGE_A8(b, h, kt)                                                                       \
  {                                                                                              \
    const char* sb_ = (const char*)A + ((size_t)((h) * 32) * lda + (size_t)(kt) * 64) * 2;       \
    __builtin_amdgcn_global_load_lds((glb_void*)(sb_ + vA0), (lds_void*)(size_t)(lb + SA8(b, h)), 16, 0, 0);                                                        \
    __builtin_amdgcn_global_load_lds((glb_void*)(sb_ + vA1), (lds_void*)(size_t)(lb + SA8(b, h) + 8192), 16, 0, 0);                                                 \
  }
#define STAGE_B8(b, h, kt)                                                                       \
  {                                                                                              \
    const char* sb_ = (const char*)Bt + ((size_t)((h) * 64) * ldb + (size_t)(kt) * 64) * 2;      \
    __builtin_amdgcn_global_load_lds((glb_void*)(sb_ + vB0), (lds_void*)(size_t)(lb + SB8(b, h)), 16, 0, 0);                                                        \
    __builtin_amdgcn_global_load_lds((glb_void*)(sb_ + vB1), (lds_void*)(size_t)(lb + SB8(b, h) + 8192), 16, 0, 0);                                                 \
  }
#define LDA8(AT, b, h)                                                                           \
  { _Pragma("unroll") for (int s = 0; s < 4; ++s) AT[s] = *(lds_frag*)(aad[s] + SA8(b, h)); }
#define LDB8(BX, b, h)                                                                           \
  { _Pragma("unroll") for (int nl = 0; nl < 2; ++nl)                                             \
      _Pragma("unroll") for (int s = 0; s < 4; ++s) BX[nl][s] = *(lds_frag*)(bad[s] + ((b) * 2 + (h)) * 16384 + nl * 4096); }
#define MMA8(ai, bj, AT, BX)                                                                     \
  {                                                                                              \
    __builtin_amdgcn_s_setprio(1);                                                               \
    _Pragma("unroll") for (int s = 0; s < 4; ++s)                                                \
      _Pragma("unroll") for (int nl = 0; nl < 2; ++nl)                                           \
        acc[ai][2 * (bj) + nl] = TR ? MFMA32(BX[nl][s], AT[s], acc[ai][2 * (bj) + nl]) : MFMA32(AT[s], BX[nl][s], acc[ai][2 * (bj) + nl]);  \
    __builtin_amdgcn_s_setprio(0);                                                               \
  }
#define LD_RA(X, b, h) LDB8(X, b, h)
#define LD_RB(X, b, h) LDA8(X, b, h)
#define ST_RA(b, h, kt) STAGE_B8(b, h, kt)
#define ST_RB(b, h, kt) STAGE_A8(b, h, kt)
#define MM(ra, rb, XA, XB) MMA8(rb, ra, XB, XA)
  bf16x8 Wf[2][4], X0[4], X1[4];
  const int nt = K >> 6;
  RAW_BARRIER();
  ST_RB(0, 0, 0) ST_RA(0, 0, 0) ST_RB(0, 1, 0) ST_RA(0, 1, 0)
  if (grp == 1) BAR8;
  WAIT_V8(4); BAR8;
  ST_RB(1, 0, 1) ST_RA(1, 0, 1) ST_RB(1, 1, 1)
  WAIT_V8(6); BAR8;
  for (int t = 0; t < nt - 2; t += 2) {
    LD_RB(X0, 0, 0) SCHED8; LD_RA(Wf, 0, 0) ST_RA(1, 1, t + 1)
    WAIT_L8(8); BAR8; WAIT_L8(0); MM(0, 0, Wf, X0) BAR8; SCHED8;
    LD_RB(X1, 0, 1) ST_RB(0, 0, t + 2)
    BAR8; WAIT_L8(0); MM(0, 1, Wf, X1) BAR8;
    LD_RA(Wf, 0, 1) ST_RA(0, 0, t + 2)
    BAR8; WAIT_L8(0); MM(1, 0, Wf, X0) BAR8; SCHED8;
    ST_RB(0, 1, t + 2)
    WAIT_V8(6); BAR8; MM(1, 1, Wf, X1) BAR8;
    LD_RB(X0, 1, 0) SCHED8; LD_RA(Wf, 1, 0) ST_RA(0, 1, t + 2)
    WAIT_L8(8); BAR8; WAIT_L8(0); MM(0, 0, Wf, X0) BAR8; SCHED8;
    LD_RB(X1, 1, 1) ST_RB(1, 0, t + 3)
    BAR8; WAIT_L8(0); MM(0, 1, Wf, X1) BAR8;
    LD_RA(Wf, 1, 1) ST_RA(1, 0, t + 3)
    BAR8; WAIT_L8(0); MM(1, 0, Wf, X0) BAR8; SCHED8;
    ST_RB(1, 1, t + 3)
    WAIT_V8(6); BAR8; MM(1, 1, Wf, X1) BAR8;
  }
  {
    LD_RB(X0, 0, 0) LD_RA(Wf, 0, 0) ST_RA(1, 1, nt - 1)
    BAR8; WAIT_L8(0); MM(0, 0, Wf, X0) BAR8;
    LD_RB(X1, 0, 1) BAR8; WAIT_L8(0); MM(0, 1, Wf, X1) BAR8;
    LD_RA(Wf, 0, 1) WAIT_V8(4); BAR8; WAIT_L8(0); MM(1, 0, Wf, X0) MM(1, 1, Wf, X1) BAR8;
  }
  {
    LD_RB(X0, 1, 0) LD_RA(Wf, 1, 0) WAIT_V8(2); BAR8; WAIT_L8(0); MM(0, 0, Wf, X0) BAR8;
    LD_RB(X1, 1, 1) WAIT_V8(0); BAR8; WAIT_L8(0); MM(0, 1, Wf, X1) BAR8;
    LD_RA(Wf, 1, 1) BAR8; WAIT_L8(0); MM(1, 0, Wf, X0) MM(1, 1, Wf, X1) BAR8;
  }
  if (grp == 0) BAR8;
#undef LD_RA
#undef LD_RB
#undef ST_RA
#undef ST_RB
#undef MM
#undef SA8
#undef SB8
#undef STAGE_A8
#undef STAGE_B8
#undef LDA8
#undef LDB8
#undef MMA8
}

template <int NI>
DI void rowss_partial(f32x16 (&acc)[2][NI], char* smem, float* ss, int stride, int slab, int row0, bool doit) {
  const int tid = otid(), lane = tid & 63, wave = tid >> 6;
  const int r = lane & 31, hh = lane >> 5;
  float* sw = (float*)(smem + 65536) + wave * (64 * 33);
#pragma unroll
  for (int mi = 0; mi < 2; ++mi)
#pragma unroll
    for (int i = 0; i < 16; ++i) {
      float t = 0.f;
#pragma unroll
      for (int ni = 0; ni < NI; ++ni) t += acc[mi][ni][i] * acc[mi][ni][i];
      sw[(mi * 32 + crow(i, hh)) * 33 + r] = t;
    }
  __syncthreads();
  float t = 0.f;
#pragma unroll
  for (int j = 0; j < 32; ++j) t += sw[lane * 33 + j];
  if (doit) ss[(size_t)(row0 + (wave >> 1) * 64 + lane) * stride + slab] = t;
  __syncthreads();
}

DI void phase_prep(const Params& p, char* smem) {
  char* ws = p.ws;
  const int gtid = blockIdx.x * NTHR + threadIdx.x, gthreads = gridDim.x * NTHR;
  const int lane = threadIdx.x & 63;
  const int gwave = gtid >> 6, nwaves = gthreads >> 6;
  u16* U = (u16*)(ws + OFF_R1);
  {
    float4 w[4];
    w[0] = *(const float4*)(p.norm_mix_w + lane * 8);
    w[1] = *(const float4*)(p.norm_mix_w + lane * 8 + 4);
    w[2] = *(const float4*)(p.norm_mix_w + 512 + lane * 8);
    w[3] = *(const float4*)(p.norm_mix_w + 512 + lane * 8 + 4);
    for (int row0 = gwave * 4; row0 < MT; row0 += nwaves * 4) {
      const bool live = row0 < M + 16;
      float4 v[4][4];
      if (live) {
#pragma unroll
        for (int k = 0; k < 4; ++k) {
          const int row = row0 + k;
          const float* src = row < M ? p.x + (size_t)row * 1024 : p.meta + (size_t)(row - M) * 1024;
          v[k][0] = *(const float4*)(src + lane * 8);
          v[k][1] = *(const float4*)(src + lane * 8 + 4);
          v[k][2] = *(const float4*)(src + 512 + lane * 8);
          v[k][3] = *(const float4*)(src + 512 + lane * 8 + 4);
        }
      }
#pragma unroll
      for (int k = 0; k < 4; ++k) {
        u32x4 o0 = {0, 0, 0, 0}, o1 = {0, 0, 0, 0};
        if (live) {
          float ss = 0.f;
#pragma unroll
          for (int q = 0; q < 4; ++q) ss += v[k][q].x * v[k][q].x + v[k][q].y * v[k][q].y + v[k][q].z * v[k][q].z + v[k][q].w * v[k][q].w;
          ss = wave_sum(ss);
          const float rs = rsqrtf(ss * (1.f / 1024.f) + 1e-6f);
          o0[0] = pack2(v[k][0].x * rs * w[0].x, v[k][0].y * rs * w[0].y);
          o0[1] = pack2(v[k][0].z * rs * w[0].z, v[k][0].w * rs * w[0].w);
          o0[2] = pack2(v[k][1].x * rs * w[1].x, v[k][1].y * rs * w[1].y);
          o0[3] = pack2(v[k][1].z * rs * w[1].z, v[k][1].w * rs * w[1].w);
          o1[0] = pack2(v[k][2].x * rs * w[2].x, v[k][2].y * rs * w[2].y);
          o1[1] = pack2(v[k][2].z * rs * w[2].z, v[k][2].w * rs * w[2].w);
          o1[2] = pack2(v[k][3].x * rs * w[3].x, v[k][3].y * rs * w[3].y);
          o1[3] = pack2(v[k][3].z * rs * w[3].z, v[k][3].w * rs * w[3].w);
        }
        *(u32x4*)(U + (size_t)(row0 + k) * 1024 + lane * 8) = o0;
        *(u32x4*)(U + (size_t)(row0 + k) * 1024 + 512 + lane * 8) = o1;
      }
    }
  }
  {
    float2* tr = (float2*)(ws + OFF_TRET);
    for (int idx = gtid; idx < NPOS * 32; idx += gthreads) {
      const int pos = idx >> 5, i = idx & 31;
      const float inv = (float)pow(10000.0, -(double)i / 32.0);
      const float ang = (float)pos * inv;
      tr[idx] = make_float2((float)cos((double)ang), (float)sin((double)ang));
    }
    float2* tm = (float2*)(ws + OFF_TMLA);
    for (int idx = gtid; idx < NPOS * 16; idx += gthreads) {
      const int pos = idx >> 4, i = idx & 15;
      const float inv = (float)pow(10000.0, -(double)i / 16.0);
      const float ang = (float)pos * inv;
      tm[idx] = make_float2((float)cos((double)ang), (float)sin((double)ang));
    }
  }
  {
    const int wave = threadIdx.x >> 6;
    char* sT = smem + wave * 9216;
    int base = 0;
    for (int job = 0; job < 8; ++job) {
      int N, K;
      u16* dst;
      switch (job) {
        case 0: N = NIN; K = 1024; dst = (u16*)(ws + OFF_WIN); break;
        case 1: N = 1024; K = 1024; dst = (u16*)(ws + OFF_WRET); break;
        case 2: N = 768; K = 384; dst = (u16*)(ws + OFF_WUQ); break;
        case 3: N = 1024; K = 256; dst = (u16*)(ws + OFF_WUKV); break;
        case 4: N = 1024; K = 512; dst = (u16*)(ws + OFF_WMLA); break;
        case 5: N = 1024; K = 1024; dst = (u16*)(ws + OFF_WO); break;
        case 6: N = 5632; K = 1024; dst = (u16*)(ws + OFF_WGU); break;
        default: N = 1024; K = DFF; dst = (u16*)(ws + OFF_WD); break;
      }
      const int ntn = N >> 6, ntiles = ntn * (K >> 6);
      int first = gwave - (base % nwaves);
      if (first < 0) first += nwaves;
      for (int tl = first; tl < ntiles; tl += nwaves) {
        const int kt = tl / ntn, n = (tl - kt * ntn) * 64 + lane, k0 = kt * 64;
        const float* src = nullptr;
        int ld = 0;
        const float* scale = nullptr;
        switch (job) {
          case 0: {
            ld = 5792;
            if (n < 3712) src = p.w_in + n;
            else if (n < 5760) src = p.w_in + n + 32;
            else if (n < 5824) {
              const int c = n - 5760;
              if (c < 16) src = p.w_in + 3712 + c;
              else if (c >= 32 && c < 48) src = p.w_in + 3712 + 16 + (c - 32);
            }
          } break;
          case 1: ld = 1024; src = p.w_ret_out + n; scale = p.gn_w; break;
          case 2: {
            ld = 768;
            scale = p.q_norm_w;
            if (n < 512) src = p.w_uq + (n >> 6) * 96 + (n & 63);
            else {
              const int g = (n - 512) >> 6, c = (n - 512) & 63;
              const int half = c >> 5, hsel = (c >> 4) & 1, j = c & 15;
              src = p.w_uq + (2 * g + hsel) * 96 + 64 + half * 16 + j;
            }
          } break;
          case 3: ld = 512; scale = p.kv_norm_w; src = n < 512 ? p.w_uk + n : p.w_uv + (n - 512); break;
          case 4: ld = 1024; src = p.w_mla_out + n; break;
          case 5: ld = 1024; src = p.w_o + n; break;
          case 6: {
            ld = DFF;
            scale = p.norm_ffn_w;
            const int blk = n >> 6, c = n & 63;
            src = c < 32 ? p.w_gate + blk * 32 + c : p.w_up + blk * 32 + (c - 32);
          } break;
          default: ld = 1024; src = p.w_down + n; break;
        }
        float v[64];
#pragma unroll
        for (int j = 0; j < 64; ++j) v[j] = src ? src[(size_t)(k0 + j) * ld] : 0.f;
        if (scale) {
          const float sc = scale[k0 + lane];
#pragma unroll
          for (int j = 0; j < 64; ++j) v[j] *= __shfl(sc, j);
        }
#pragma unroll
        for (int j = 0; j < 32; ++j) *(unsigned*)(sT + lane * 144 + j * 4) = pack2(v[2 * j], v[2 * j + 1]);
#pragma unroll
        for (int q = 0; q < 8; ++q) {
          const int row = q * 8 + (lane >> 3), c = lane & 7;
          const u32x4 o = *(const u32x4*)(sT + row * 144 + c * 16);
          *(u32x4*)(dst + (size_t)((tl - kt * ntn) * 64 + row) * K + k0 + c * 8) = o;
        }
      }
      base += ntiles;
    }
  }
}

DI void phase_proj(const Params& p, char* smem) {
  char* ws = p.ws;
  const u16* U = (const u16*)(ws + OFF_R1);
  const u16* W = (const u16*)(ws + OFF_WIN);
  u16* RQ = (u16*)(ws + OFF_RQ);
  u16* RK = (u16*)(ws + OFF_RK);
  u16* RKT = (u16*)(ws + OFF_RKT);
  u16* RVT = (u16*)(ws + OFF_RVT);
  u16* RG = (u16*)(ws + OFF_RG);
  u16* CQ = (u16*)(ws + OFF_CQ);
  u16* CKV = (u16*)(ws + OFF_CKV);
  u16* KR = (u16*)(ws + OFF_KR);
  u16* GRET = (u16*)(ws + OFF_GRET);
  u16* GMLA = (u16*)(ws + OFF_GMLA);
  float* SSQ = (float*)(ws + OFF_SSQ);
  float* SSKV = (float*)(ws + OFF_SSKV);
  const float2* TR = (const float2*)(ws + OFF_TRET);
  const float2* TM = (const float2*)(ws + OFF_TMLA);
  const int tid = otid(), lane = tid & 63, wave = tid >> 6;
  const int wm = wave >> 1, wn = wave & 1, r = lane & 31, hh = lane >> 5;
  constexpr int NT = NIN / 256;
  constexpr int LIM = 33 * 4 * NT;
  int tfirst = vbid();
  {
    int mt_, nt_;
    while (tfirst < LIM && !tile_map(tfirst, MT / 256, NT, mt_, nt_)) tfirst += gridDim.x;
  }
  bool staged = false;
  for (int t = tfirst, tn = 0; t < LIM; t = tn) {
    int mt, nt;
    tile_map(t, MT / 256, NT, mt, nt);
    const int m0 = mt * 256, n0 = nt * 256;
    const u16 *nA = nullptr, *nB = nullptr;
    {
      int mt2 = 0, nt2 = 0;
      tn = t + gridDim.x;
      while (tn < LIM && !tile_map(tn, MT / 256, NT, mt2, nt2)) tn += gridDim.x;
      if (tn < LIM) { nA = U + (size_t)mt2 * 256 * 1024; nB = W + (size_t)nt2 * 256 * 1024; }
    }
    f32x16 acc[2][4];
#pragma unroll
    for (int mi = 0; mi < 2; ++mi)
#pragma unroll
      for (int ni = 0; ni < 4; ++ni) zero_acc(acc[mi][ni]);
    gemm8<false>(U + (size_t)m0 * 1024, 1024, W + (size_t)n0 * 1024, 1024, 1024, acc, smem);
    const int col0 = n0 + wn * 128;
    const int rowb = m0 + wm * 64;
    if (n0 >= 3072 && n0 < 3712) {
      const bool isq = col0 < 3456;
      const bool iskv = col0 >= 3456 && col0 < 3712;
      rowss_partial<4>(acc, smem, isq ? SSQ : SSKV, 4, isq ? (col0 - 3072) >> 7 : (col0 - 3456) >> 7, m0, isq || iskv);
    }
    if (col0 < 1024) {
      const bool isk = col0 >= 512;
#pragma unroll
      for (int mi = 0; mi < 2; ++mi) {
        float o1[2][16], o2[2][16];
#pragma unroll
        for (int i = 0; i < 16; ++i) {
          const int row = rowb + mi * 32 + crow(i, hh);
          const float2 cs = TR[row_pos(row) * 32 + r];
#pragma unroll
          for (int gi = 0; gi < 2; ++gi) {
            float x1 = acc[mi][2 * gi][i], x2 = acc[mi][2 * gi + 1][i];
            float a = x1 * cs.x - x2 * cs.y, b = x1 * cs.y + x2 * cs.x;
            if (isk) { a *= 0.125f; b *= 0.125f; }
            o1[gi][i] = a; o2[gi][i] = b;
          }
        }
        const int rowm = rowb + mi * 32;
#pragma unroll
        for (int gi = 0; gi < 2; ++gi) {
          const int hc = (col0 & 511) + gi * 64;
          if (rowm < M) {
            u16* dst = (isk ? RK : RQ) + (size_t)(rowm + 4 * hh) * 512 + hc + r;
#pragma unroll
            for (int i = 0; i < 16; ++i) {
              const int ro = (i & 3) + 8 * (i >> 2);
              dst[(size_t)ro * 512] = f2bf(o1[gi][i]);
              dst[(size_t)ro * 512 + 32] = f2bf(o2[gi][i]);
            }
          }
          if (isk) {
            store_tokblk(RKT + ((size_t)(rowm >> 3) * 512 + hc + r) * 8, 512, o1[gi], hh);
            store_tokblk(RKT + ((size_t)(rowm >> 3) * 512 + hc + 32 + r) * 8, 512, o2[gi], hh);
          }
        }
      }
    } else if (col0 < 2048) {
#pragma unroll
      for (int mi = 0; mi < 2; ++mi)
#pragma unroll
        for (int ni = 0; ni < 4; ++ni) {
          float v[16];
#pragma unroll
          for (int i = 0; i < 16; ++i) v[i] = acc[mi][ni][i];
          store_tokblk(RVT + ((size_t)((rowb + mi * 32) >> 3) * 1024 + (col0 - 1024 + ni * 32 + r)) * 8, 1024, v, hh);
        }
    } else if (col0 < 3072) {
      u16* dstb = RG + (col0 - 2048);
#pragma unroll
      for (int mi = 0; mi < 2; ++mi)
#pragma unroll
        for (int i = 0; i < 16; ++i) {
          const int row = rowb + mi * 32 + crow(i, hh);
          if (row < M) {
#pragma unroll
            for (int ni = 0; ni < 4; ++ni) dstb[(size_t)row * 1024 + ni * 32 + r] = f2bf(siluf_(acc[mi][ni][i]));
          }
        }
    } else if (col0 >= 3712 && col0 < 5760) {
      if (m0 < M) {
        const bool isret = col0 < 4736;
        u16* gb = isret ? GRET : GMLA;
        const int cb = (col0 - (isret ? 3712 : 4736)) >> 5;
        const int R = rowb >> 6;
#pragma unroll
        for (int mi = 0; mi < 2; ++mi)
#pragma unroll
          for (int ni = 0; ni < 4; ++ni) {
            u32x4 o0, o1;
            o0[0] = pack2(sigmoidf_(acc[mi][ni][0]), sigmoidf_(acc[mi][ni][1]));
            o0[1] = pack2(sigmoidf_(acc[mi][ni][2]), sigmoidf_(acc[mi][ni][3]));
            o0[2] = pack2(sigmoidf_(acc[mi][ni][4]), sigmoidf_(acc[mi][ni][5]));
            o0[3] = pack2(sigmoidf_(acc[mi][ni][6]), sigmoidf_(acc[mi][ni][7]));
            o1[0] = pack2(sigmoidf_(acc[mi][ni][8]), sigmoidf_(acc[mi][ni][9]));
            o1[1] = pack2(sigmoidf_(acc[mi][ni][10]), sigmoidf_(acc[mi][ni][11]));
            o1[2] = pack2(sigmoidf_(acc[mi][ni][12]), sigmoidf_(acc[mi][ni][13]));
            o1[3] = pack2(sigmoidf_(acc[mi][ni][14]), sigmoidf_(acc[mi][ni][15]));
            u16* d = gb + ((((size_t)R * 32 + cb + ni) * 2 + mi) * 64 + lane) * 16;
            *(u32x4*)d = o0;
            *(u32x4*)(d + 8) = o1;
          }
      }
    } else if (col0 < 3712) {
      const bool isq = col0 < 3456;
      u16* dstb = isq ? CQ + (col0 - 3072) : CKV + (col0 - 3456);
      const int ld = isq ? 384 : 256;
#pragma unroll
      for (int mi = 0; mi < 2; ++mi)
#pragma unroll
        for (int i = 0; i < 16; ++i) {
          const int row = rowb + mi * 32 + crow(i, hh);
#pragma unroll
          for (int ni = 0; ni < 4; ++ni) dstb[(size_t)row * ld + ni * 32 + r] = f2bf(acc[mi][ni][i]);
        }
    } else if (col0 == 5760) {
      if (r < 16) {
#pragma unroll
        for (int mi = 0; mi < 2; ++mi)
#pragma unroll
          for (int i = 0; i < 16; ++i) {
            const int row = rowb + mi * 32 + crow(i, hh);
            const float2 cs = TM[row_pos(row) * 16 + r];
            const float x1 = acc[mi][0][i], x2 = acc[mi][1][i];
            KR[(size_t)row * 32 + r] = f2bf(x1 * cs.x - x2 * cs.y);
            KR[(size_t)row * 32 + 16 + r] = f2bf(x1 * cs.y + x2 * cs.x);
          }
      }
    }
  }
}

DI void phase_ret_incr(const Params& p, char* smem) {
  char* ws = p.ws;
  const u16* RKT = (const u16*)(ws + OFF_RKT);
  const u16* RVT = (const u16*)(ws + OFF_RVT);
  u16* INCR = (u16*)(ws + OFF_INCR);
  const int half = threadIdx.x >> 8;
  smem += half * 51200;
  char* sV = smem;
  char* sK = smem + 32768;
  float* sW = (float*)(smem + 49152);
  const int tid = otid() & 255, lane = tid & 63, wave = tid >> 6;
  const int r = lane & 31, hh = lane >> 5;
  const float LOG2E = 1.4426950408889634f;
  for (int pi = blockIdx.x; pi < 4 * 64 * 4; pi += gridDim.x) {
    const int item = 2 * pi + half;
    const int h = item & 7, c = (item >> 3) & 63, b = item >> 9;
    const int col0 = b * SEQ + c * 128;
    const float lgf2 = -__expf(p.decay_f[h]) * LOG2E, lgb2 = -__expf(p.decay_b[h]) * LOG2E;
    __syncthreads();
    if (tid < 128) {
      sW[tid] = exp2f(lgf2 * (float)(127 - tid));
      sW[128 + tid] = exp2f(lgb2 * (float)tid);
    }
    {
      const int tb0 = col0 >> 3;
      const int ve = tid & 127, vc0 = tid >> 7;
#pragma unroll
      for (int q = 0; q < 8; ++q) {
        const int c_ = vc0 + 2 * q;
        u32x4 v = *(const u32x4*)(RVT + ((size_t)(tb0 + c_) * 1024 + h * 128 + ve) * 8);
        *(u32x4*)(sV + ve * 256 + ((c_ ^ (ve & 15)) << 4)) = v;
      }
      const int kd = tid & 63, kc0 = tid >> 6;
#pragma unroll
      for (int q = 0; q < 4; ++q) {
        const int c_ = kc0 + 4 * q;
        u32x4 v = *(const u32x4*)(RKT + ((size_t)(tb0 + c_) * 512 + h * 64 + kd) * 8);
        *(u32x4*)(sK + kd * 256 + ((c_ ^ (kd & 15)) << 4)) = v;
      }
    }
    __syncthreads();
    f32x16 af[2], ab[2];
    zero_acc(af[0]); zero_acc(af[1]); zero_acc(ab[0]); zero_acc(ab[1]);
#pragma unroll
    for (int s = 0; s < 8; ++s) {
      const int ch = 2 * s + hh;
      const int e = wave * 32 + r;
      const bf16x8 a = *(const bf16x8*)(sV + e * 256 + ((ch ^ (e & 15)) << 4));
      const float4 wf0 = *(const float4*)(sW + ch * 8), wf1 = *(const float4*)(sW + ch * 8 + 4);
      const float4 wb0 = *(const float4*)(sW + 128 + ch * 8), wb1 = *(const float4*)(sW + 128 + ch * 8 + 4);
#pragma unroll
      for (int nb = 0; nb < 2; ++nb) {
        const int d = nb * 32 + r;
        const u32x4 kv = *(const u32x4*)(sK + d * 256 + ((ch ^ (d & 15)) << 4));
        u32x4 kf, kb;
        kf[0] = pack2(bflo(kv[0]) * wf0.x, bfhi(kv[0]) * wf0.y);
        kf[1] = pack2(bflo(kv[1]) * wf0.z, bfhi(kv[1]) * wf0.w);
        kf[2] = pack2(bflo(kv[2]) * wf1.x, bfhi(kv[2]) * wf1.y);
        kf[3] = pack2(bflo(kv[3]) * wf1.z, bfhi(kv[3]) * wf1.w);
        kb[0] = pack2(bflo(kv[0]) * wb0.x, bfhi(kv[0]) * wb0.y);
        kb[1] = pack2(bflo(kv[1]) * wb0.z, bfhi(kv[1]) * wb0.w);
        kb[2] = pack2(bflo(kv[2]) * wb1.x, bfhi(kv[2]) * wb1.y);
        kb[3] = pack2(bflo(kv[3]) * wb1.z, bfhi(kv[3]) * wb1.w);
        af[nb] = MFMA32(a, __builtin_bit_cast(bf16x8, kf), af[nb]);
        ab[nb] = MFMA32(a, __builtin_bit_cast(bf16x8, kb), ab[nb]);
      }
    }
    const int fslot = c <= 62 ? c + 1 : -1;
    const int bslot = c >= 1 ? c - 1 : -1;
#pragma unroll
    for (int nb = 0; nb < 2; ++nb)
#pragma unroll
      for (int i = 0; i < 16; ++i) {
        const int e = wave * 32 + crow(i, hh), d = nb * 32 + r;
        if (fslot >= 0) INCR[((size_t)((0 * 4 + b) * 64 + fslot) * 8 + h) * 8192 + e * 64 + d] = f2bf(af[nb][i]);
        if (bslot >= 0) INCR[((size_t)((1 * 4 + b) * 64 + bslot) * 8 + h) * 8192 + e * 64 + d] = f2bf(ab[nb][i]);
      }
  }
}

DI void phase_ret_scan(const Params& p) {
  unsigned* INCR = (unsigned*)(p.ws + OFF_INCR);
  const int gtid = blockIdx.x * NTHR + threadIdx.x, gthreads = gridDim.x * NTHR;
  const float LOG2E = 1.4426950408889634f;
  for (int idx = gtid; idx < 2 * 4 * 8 * 4096; idx += gthreads) {
    const int pr = idx & 4095, h = (idx >> 12) & 7, b = (idx >> 15) & 3, dir = idx >> 17;
    const float lg2 = -__expf(dir ? p.decay_b[h] : p.decay_f[h]) * LOG2E;
    const float g = exp2f(lg2 * 128.f);
    unsigned* base = INCR + (size_t)(dir * 4 + b) * 64 * 8 * 4096 + (size_t)h * 4096 + pr;
    float s0 = 0.f, s1 = 0.f;
    if (dir) {
      base[(size_t)63 * 8 * 4096] = 0u;
    } else {
      const int e = pr >> 5, d = (pr & 31) * 2;
      const u16* RKT = (const u16*)(p.ws + OFF_RKT);
      const u16* RVT = (const u16*)(p.ws + OFF_RVT);
#pragma unroll
      for (int tb = 0; tb < 2; ++tb) {
        const u32x4 vv = *(const u32x4*)(RVT + ((size_t)((M >> 3) + tb) * 1024 + h * 128 + e) * 8);
        const u32x4 k0 = *(const u32x4*)(RKT + ((size_t)((M >> 3) + tb) * 512 + h * 64 + d) * 8);
        const u32x4 k1 = *(const u32x4*)(RKT + ((size_t)((M >> 3) + tb) * 512 + h * 64 + d + 1) * 8);
#pragma unroll
        for (int j = 0; j < 4; ++j) {
          const float w0 = exp2f(lg2 * (float)(15 - (tb * 8 + 2 * j))), w1 = exp2f(lg2 * (float)(15 - (tb * 8 + 2 * j + 1)));
          s0 += w0 * bflo(vv[j]) * bflo(k0[j]) + w1 * bfhi(vv[j]) * bfhi(k0[j]);
          s1 += w0 * bflo(vv[j]) * bflo(k1[j]) + w1 * bfhi(vv[j]) * bfhi(k1[j]);
        }
      }
      base[0] = pack2(s0, s1);
    }
#pragma unroll 1
    for (int bt = 0; bt < 4; ++bt) {
      unsigned* q = dir ? base + (size_t)(62 - bt * 16) * 8 * 4096 : base + (size_t)(1 + bt * 16) * 8 * 4096;
      const long st = dir ? -(long)(8 * 4096) : (long)(8 * 4096);
      const int cnt = bt == 3 ? 15 : 16;
      unsigned u[16];
#pragma unroll
      for (int n = 0; n < 16; ++n) u[n] = (n < cnt) ? q[n * st] : 0u;
#pragma unroll
      for (int n = 0; n < 16; ++n) {
        s0 = g * s0 + bflo(u[n]); s1 = g * s1 + bfhi(u[n]);
        u[n] = pack2(s0, s1);
      }
#pragma unroll
      for (int n = 0; n < 16; ++n) if (n < cnt) q[n * st] = u[n];
    }
  }
}

DI void phase_ret_out(const Params& p, char* smem) {
  char* ws = p.ws;
  const u16* RQ = (const u16*)(ws + OFF_RQ);
  const u16* RK = (const u16*)(ws + OFF_RK);
  const u16* RVT = (const u16*)(ws + OFF_RVT);
  const u16* ST = (const u16*)(ws + OFF_INCR);
  u16* RG = (u16*)(ws + OFF_RG);
  const int half = threadIdx.x >> 8;
  smem += half * 51200;
  const int tid = otid() & 255, lane = tid & 63, wave = tid >> 6;
  const int r = lane & 31, hh = lane >> 5;
  const float LOG2E = 1.4426950408889634f;
  for (int pi = blockIdx.x; pi < 4 * 64 * 4; pi += gridDim.x) {
    const int item = 2 * pi + half;
    const int h = item & 7, n = (item >> 3) & 63, b = item >> 9;
    const int row0 = b * SEQ + n * 128;
    const float lgf2 = -__expf(p.decay_f[h]) * LOG2E, lgb2 = -__expf(p.decay_b[h]) * LOG2E;
    const int qi = wave * 32 + r;
    bf16x8 qf[4];
#pragma unroll
    for (int s = 0; s < 4; ++s) qf[s] = *(const bf16x8*)(RQ + (size_t)(row0 + qi) * 512 + h * 64 + (2 * s + hh) * 8);
    __syncthreads();
    char* sF = smem;
    char* sB = smem + 16384;
    {
      const int lr = tid >> 3, lc = tid & 7;
      const u16* gf = ST + ((size_t)((0 * 4 + b) * 64 + n) * 8 + h) * 8192;
      const u16* gb = ST + ((size_t)((1 * 4 + b) * 64 + n) * 8 + h) * 8192;
#pragma unroll
      for (int q = 0; q < 4; ++q) {
        const int row = lr + 32 * q;
        const int so = row * 128 + ((lc ^ ((row >> 1) & 7)) << 4);
        *(u32x4*)(sF + so) = *(const u32x4*)(gf + row * 64 + lc * 8);
        *(u32x4*)(sB + so) = *(const u32x4*)(gb + row * 64 + lc * 8);
      }
    }
    __syncthreads();
    f32x16 O[4];
    {
      const float wq = __builtin_amdgcn_exp2f(lgf2 * (float)(qi + 1));
      const float wqb = __builtin_amdgcn_exp2f(lgb2 * (float)(128 - qi));
#pragma unroll
      for (int eb = 0; eb < 4; ++eb) {
        const int e = eb * 32 + r;
        f32x16 t;
        zero_acc(t);
#pragma unroll
        for (int s = 0; s < 4; ++s) {
          const bf16x8 a = *(const bf16x8*)(sF + e * 128 + (((2 * s + hh) ^ ((e >> 1) & 7)) << 4));
          t = MFMA32(a, qf[s], t);
        }
#pragma unroll
        for (int i = 0; i < 16; ++i) O[eb][i] = t[i] * wq;
        zero_acc(t);
#pragma unroll
        for (int s = 0; s < 4; ++s) {
          const bf16x8 a = *(const bf16x8*)(sB + e * 128 + (((2 * s + hh) ^ ((e >> 1) & 7)) << 4));
          t = MFMA32(a, qf[s], t);
        }
#pragma unroll
        for (int i = 0; i < 16; ++i) O[eb][i] += t[i] * wqb;
        __builtin_amdgcn_sched_barrier(0);
      }
    }
    __syncthreads();
    char* sK = smem;
    char* sV = smem + 16384;
    {
      const int lr = tid >> 3, lc = tid & 7;
#pragma unroll
      for (int q = 0; q < 4; ++q) {
        const int row = lr + 32 * q;
        *(u32x4*)(sK + row * 128 + ((lc ^ ((row >> 1) & 7)) << 4)) = *(const u32x4*)(RK + (size_t)(row0 + row) * 512 + h * 64 + lc * 8);
      }
      const int ve = tid & 127, vc0 = tid >> 7;
#pragma unroll
      for (int q = 0; q < 8; ++q) {
        const int c_ = vc0 + 2 * q;
        *(u32x4*)(sV + ve * 256 + ((c_ ^ (ve & 15)) << 4)) = *(const u32x4*)(RVT + ((size_t)((row0 >> 3) + c_) * 1024 + h * 128 + ve) * 8);
      }
    }
    __syncthreads();
    const int r_sw = (r & 0x13) | ((r & 4) << 1) | ((r & 8) >> 1);
#pragma unroll 1
    for (int kb = 0; kb < 4; ++kb) {
      f32x16 S;
      zero_acc(S);
      const int krow = kb * 32 + r_sw;
#pragma unroll
      for (int s = 0; s < 4; ++s) {
        const bf16x8 a = *(const bf16x8*)(sK + krow * 128 + (((2 * s + hh) ^ ((krow >> 1) & 7)) << 4));
        S = MFMA32(a, qf[s], S);
      }
      u32x4 pf[2];
#pragma unroll
      for (int t = 0; t < 2; ++t) {
        float pv[8];
#pragma unroll
        for (int jj = 0; jj < 8; ++jj) {
          const int key = kb * 32 + 16 * t + 8 * hh + jj;
          const int dlt = qi - key;
          const float w = __builtin_amdgcn_exp2f(dlt >= 0 ? lgf2 * (float)dlt : lgb2 * (float)(-dlt));
          pv[jj] = S[8 * t + jj] * w;
        }
        pf[t][0] = pack2(pv[0], pv[1]); pf[t][1] = pack2(pv[2], pv[3]);
        pf[t][2] = pack2(pv[4], pv[5]); pf[t][3] = pack2(pv[6], pv[7]);
      }
#pragma unroll
      for (int t = 0; t < 2; ++t) {
        const int ch = 2 * (2 * kb + t) + hh;
#pragma unroll
        for (int eb = 0; eb < 4; ++eb) {
          const int e = eb * 32 + r;
          const bf16x8 a = *(const bf16x8*)(sV + e * 256 + ((ch ^ (e & 15)) << 4));
          O[eb] = MFMA32(a, __builtin_bit_cast(bf16x8, pf[t]), O[eb]);
        }
        __builtin_amdgcn_sched_barrier(0);
      }
    }
    float sum = 0.f;
#pragma unroll
    for (int eb = 0; eb < 4; ++eb)
#pragma unroll
      for (int i = 0; i < 16; ++i) sum += O[eb][i];
    sum += __shfl_xor(sum, 32);
    const float mu = sum * (1.f / 128.f);
    float var = 0.f;
#pragma unroll
    for (int eb = 0; eb < 4; ++eb)
#pragma unroll
      for (int i = 0; i < 16; ++i) { const float d = O[eb][i] - mu; var += d * d; }
    var += __shfl_xor(var, 32);
    const float rstd = rsqrtf(var * (1.f / 128.f) + 1e-5f);
    u16* grow = RG + (size_t)(row0 + qi) * 1024 + h * 128;
#pragma unroll
    for (int eb = 0; eb < 4; ++eb)
#pragma unroll
      for (int g4 = 0; g4 < 4; ++g4) {
        u32x2* gp = (u32x2*)(grow + eb * 32 + 8 * g4 + 4 * hh);
        const u32x2 gv = *gp;
        const float y0 = (O[eb][4 * g4] - mu) * rstd * bflo(gv[0]);
        const float y1 = (O[eb][4 * g4 + 1] - mu) * rstd * bfhi(gv[0]);
        const float y2 = (O[eb][4 * g4 + 2] - mu) * rstd * bflo(gv[1]);
        const float y3 = (O[eb][4 * g4 + 3] - mu) * rstd * bfhi(gv[1]);
        u32x2 o = {pack2(y0, y1), pack2(y2, y3)};
        *gp = o;
        __builtin_amdgcn_sched_barrier(0);
      }
  }
}

DI void phase_mla_proj(const Params& p, char* smem) {
  char* ws = p.ws;
  const u16* KR = (const u16*)(ws + OFF_KR);
  u16* Q = (u16*)(ws + OFF_Q);
  u16* Kb = (u16*)(ws + OFF_K);
  u16* VT = (u16*)(ws + OFF_VT);
  u16* KM = (u16*)(ws + OFF_KM);
  u16* VM = (u16*)(ws + OFF_VM);
  const float2* TM = (const float2*)(ws + OFF_TMLA);
  const int tid = otid(), lane = tid & 63, wave = tid >> 6;
  const int wm = wave >> 1, wn = wave & 1, r = lane & 31, hh = lane >> 5;
  float* sRS = (float*)(smem + 133120);
  const float QSCALE = 0.10206207261596577f * 1.4426950408889634f;
  bool staged = false;
  for (int t = vbid(); t < 128 * 6; t += gridDim.x) {
    int mt, nt;
    tile_map(t, 128, 6, mt, nt);
    const int m0 = mt * 256, n0 = nt * 128;
    const u16 *nA = nullptr, *nB = nullptr;
    if (t + (int)gridDim.x < 128 * 6) {
      int mt2, nt2;
      tile_map(t + gridDim.x, 128, 6, mt2, nt2);
      nA = (const u16*)(ws + OFF_CQ) + (size_t)mt2 * 256 * 384; nB = (const u16*)(ws + OFF_WUQ) + (size_t)nt2 * 128 * 384;
    }
    RAW_BARRIER();
    if (tid < 256) {
      const float* ss = (const float*)(ws + OFF_SSQ) + (size_t)(m0 + tid) * 4;
      sRS[tid] = rsqrtf((ss[0] + ss[1] + ss[2]) * (1.f / 384.f) + 1e-6f) * QSCALE;
    }
    f32x16 acc[2][2];
#pragma unroll
    for (int mi = 0; mi < 2; ++mi)
#pragma unroll
      for (int ni = 0; ni < 2; ++ni) zero_acc(acc[mi][ni]);
    gemm_core<2>((const u16*)(ws + OFF_CQ) + (size_t)m0 * 384, 384, (const u16*)(ws + OFF_WUQ) + (size_t)n0 * 384, 384, 384, acc, smem, staged, nA, 384, nB, 384);
    staged = nA != nullptr;
    const int col0 = n0 + wn * 64;
    const int rl0 = wm * 64;
    if (col0 < 512) {
      u16* qbase = Q + (size_t)(m0 + rl0 + 4 * hh) * 768 + (col0 >> 6) * 96 + r;
#pragma unroll
      for (int mi = 0; mi < 2; ++mi)
#pragma unroll
        for (int i = 0; i < 16; ++i) {
          const int rlc = mi * 32 + (i & 3) + 8 * (i >> 2);
          const float rs = sRS[rl0 + 4 * hh + rlc];
          qbase[rlc * 768] = f2bf(acc[mi][0][i] * rs);
          qbase[rlc * 768 + 32] = f2bf(acc[mi][1][i] * rs);
        }
    } else {
      const int g = (col0 - 512) >> 6;
      const int head = 2 * g + (r >> 4), j = r & 15;
      u16* qbase = Q + (size_t)(m0 + rl0 + 4 * hh) * 768 + head * 96 + 64 + j;
#pragma unroll
      for (int mi = 0; mi < 2; ++mi)
#pragma unroll
        for (int i = 0; i < 16; ++i) {
          const int rlc = mi * 32 + (i & 3) + 8 * (i >> 2);
          const int rl = rl0 + 4 * hh + rlc;
          const float rs = sRS[rl];
          const float2 cs = TM[row_pos(m0 + rl) * 16 + j];
          const float x1 = acc[mi][0][i] * rs, x2 = acc[mi][1][i] * rs;
          qbase[rlc * 768] = f2bf(x1 * cs.x - x2 * cs.y);
          qbase[rlc * 768 + 16] = f2bf(x1 * cs.y + x2 * cs.x);
        }
    }
  }
  staged = false;
  for (int t = vbid(); t < 128 * 8; t += gridDim.x) {
    int mt, nt;
    tile_map(t, 128, 8, mt, nt);
    const int m0 = mt * 256, n0 = nt * 128;
    const u16 *nA = nullptr, *nB = nullptr;
    if (t + (int)gridDim.x < 128 * 8) {
      int mt2, nt2;
      tile_map(t + gridDim.x, 128, 8, mt2, nt2);
      nA = (const u16*)(ws + OFF_CKV) + (size_t)mt2 * 256 * 256; nB = (const u16*)(ws + OFF_WUKV) + (size_t)nt2 * 128 * 256;
    }
    RAW_BARRIER();
    if (tid < 256) {
      const float* ss = (const float*)(ws + OFF_SSKV) + (size_t)(m0 + tid) * 4;
      sRS[tid] = rsqrtf((ss[0] + ss[1]) * (1.f / 256.f) + 1e-6f);
    }
    f32x16 acc[2][2];
#pragma unroll
    for (int mi = 0; mi < 2; ++mi)
#pragma unroll
      for (int ni = 0; ni < 2; ++ni) zero_acc(acc[mi][ni]);
    gemm_core<2>((const u16*)(ws + OFF_CKV) + (size_t)m0 * 256, 256, (const u16*)(ws + OFF_WUKV) + (size_t)n0 * 256, 256, 256, acc, smem, staged, nA, 256, nB, 256);
    staged = nA != nullptr;
    const int col0 = n0 + wn * 64;
    const int rl0 = wm * 64;
    const int bb = m0 >> 13, key0 = m0 & (SEQ - 1);
    if (col0 < 512) {
      u16* kbase = Kb + ((size_t)(bb * 8 + (col0 >> 6)) * SEQ + key0 + rl0 + 4 * hh) * 96 + r;
#pragma unroll
      for (int mi = 0; mi < 2; ++mi)
#pragma unroll
        for (int i = 0; i < 16; ++i) {
          const int rlc = mi * 32 + (i & 3) + 8 * (i >> 2);
          const float rs = sRS[rl0 + 4 * hh + rlc];
          kbase[rlc * 96] = f2bf(acc[mi][0][i] * rs);
          kbase[rlc * 96 + 32] = f2bf(acc[mi][1][i] * rs);
        }
    } else {
      u16* vhead = VT + (size_t)(bb * 8 + ((col0 - 512) >> 6)) * 64 * SEQ;
#pragma unroll
      for (int mi = 0; mi < 2; ++mi) {
        const int rlm = rl0 + mi * 32;
        const float4 rsa = *(const float4*)(sRS + rlm + 4 * hh), rsb = *(const float4*)(sRS + rlm + 8 + 4 * hh);
        const float4 rsc = *(const float4*)(sRS + rlm + 16 + 4 * hh), rsd = *(const float4*)(sRS + rlm + 24 + 4 * hh);
        const float rsv[16] = {rsa.x, rsa.y, rsa.z, rsa.w, rsb.x, rsb.y, rsb.z, rsb.w, rsc.x, rsc.y, rsc.z, rsc.w, rsd.x, rsd.y, rsd.z, rsd.w};
#pragma unroll
        for (int ni = 0; ni < 2; ++ni) {
          float v[16];
#pragma unroll
          for (int i = 0; i < 16; ++i) v[i] = acc[mi][ni][i] * rsv[i];
          store_tokblk(vhead + ((size_t)((key0 + rlm) >> 3) * 64 + ni * 32 + r) * 8, 64, v, hh);
        }
      }
    }
  }
  {
    const int gtid = blockIdx.x * NTHR + tid, gthreads = gridDim.x * NTHR;
    const u16* CKV = (const u16*)(ws + OFF_CKV);
    const u16* WUKV = (const u16*)(ws + OFF_WUKV);
    const float* SSKV = (const float*)(ws + OFF_SSKV);
    for (int idx = gtid; idx < 64 * 1024; idx += gthreads) {
      const int row = idx >> 10, n = idx & 1023;
      float v = 0.f;
      if (row < 16) {
        const u32x4* a = (const u32x4*)(CKV + (size_t)(M + row) * 256);
        const u32x4* w = (const u32x4*)(WUKV + (size_t)n * 256);
        float acc = 0.f;
        for (int k = 0; k < 32; ++k) {
          const u32x4 av = a[k], wv = w[k];
#pragma unroll
          for (int j = 0; j < 4; ++j) acc += bflo(av[j]) * bflo(wv[j]) + bfhi(av[j]) * bfhi(wv[j]);
        }
        const float* ss = SSKV + (size_t)(M + row) * 4;
        v = acc * rsqrtf((ss[0] + ss[1]) * (1.f / 256.f) + 1e-6f);
      }
      if (n < 512) KM[(size_t)((n >> 6) * 64 + row) * 96 + (n & 63)] = f2bf(v);
      else VM[(size_t)((n - 512) >> 6) * 64 * 64 + ((size_t)(row >> 3) * 64 + ((n - 512) & 63)) * 8 + (row & 7)] = f2bf(v);
    }
  }
  {
    const int gtid = blockIdx.x * NTHR + tid, gthreads = gridDim.x * NTHR;
    const int total = (M + 64) * 8 * 4;
    for (int idx = gtid; idx < total; idx += gthreads) {
      const int c = idx & 3, head = (idx >> 2) & 7, row = idx >> 5;
      const u32x4 v = *(const u32x4*)(KR + (size_t)row * 32 + c * 8);
      if (row < M) {
        const int bb = row >> 13, key = row & (SEQ - 1);
        *(u32x4*)(Kb + ((size_t)(bb * 8 + head) * SEQ + key) * 96 + 64 + c * 8) = v;
      } else {
        *(u32x4*)(KM + (size_t)(head * 64 + (row - M)) * 96 + 64 + c * 8) = v;
      }
    }
  }
}

DI void phase_attn(const Params& p, char* smem) {
  char* ws = p.ws;
  const u16* Q = (const u16*)(ws + OFF_Q);
  const u16* Kb = (const u16*)(ws + OFF_K);
  const u16* VT = (const u16*)(ws + OFF_VT);
  const u16* KM = (const u16*)(ws + OFF_KM);
  const u16* VM = (const u16*)(ws + OFF_VM);
  u16* AO = (u16*)(ws + OFF_AO);
  char* sK0 = smem;
  char* sK1 = smem + 12288;
  char* sV0 = smem + 24576;
  char* sV1 = smem + 32768;
  const int tid = otid(), lane = tid & 63, wave = tid >> 6;
  const int r = lane & 31, hh = lane >> 5;
  const int r_sw = (r & 0x13) | ((r & 4) << 1) | ((r & 8) >> 1);
  const int kw0 = (tid / 12) * 192 + (((tid % 12) ^ (((tid / 12) >> 2) & 3)) << 4);
  const int ci1 = tid + 512;
  const int kw1 = (ci1 / 12) * 192 + (((ci1 % 12) ^ (((ci1 / 12) >> 2) & 3)) << 4);
  const int vw = (tid & 63) * 128 + (((tid >> 6) ^ (((tid & 63) >> 1) & 7)) << 4);
  const bool k2 = tid < 256;
  const int grp = __builtin_amdgcn_readfirstlane(wave) >> 2;
  const int kr0 = r_sw * 192, kr1 = (32 + r_sw) * 192, ksw = (r_sw >> 2) & 3;
  const int vr0 = r * 128, vr1 = (32 + r) * 128, vsw = (r >> 1) & 7;
  const u32x4 ones_u = {0x3F803F80u, 0x3F803F80u, 0x3F803F80u, 0x3F803F80u};
  const bf16x8 ones = __builtin_bit_cast(bf16x8, ones_u);
  for (int item = vbid(); item < 32 * 32; item += gridDim.x) {
    const int qb = item & 31, bh = item >> 5;
    const int b = bh >> 3, h = bh & 7;
    const int qrow = b * SEQ + qb * 256 + wave * 32 + r;
    bf16x8 qf[6];
#pragma unroll
    for (int s = 0; s < 6; ++s) qf[s] = *(const bf16x8*)(Q + (size_t)qrow * 768 + h * 96 + (2 * s + hh) * 8);
    const u16* Kg = Kb + (size_t)bh * SEQ * 96;
    const u16* Vg = VT + (size_t)bh * 64 * SEQ;
    const u16* Kmeta = KM + (size_t)h * 64 * 96;
    const u16* Vmeta = VM + (size_t)h * 64 * 64;
    f32x16 O[2], negm;
    zero_acc(O[0]); zero_acc(O[1]); zero_acc(negm);
    float mrun = 0.f, lrun = 0.f;
    u32x4 rk0, rk1, rv;
#define A_LOADK(T, RK0, RK1)                                                        \
  if ((T) <= 128) {                                                                 \
    const u16* ks_ = (T) == 128 ? Kmeta : Kg + (size_t)(T) * 64 * 96;               \
    RK0 = *(const u32x4*)(ks_ + (size_t)tid * 8);                                   \
    if (k2) RK1 = *(const u32x4*)(ks_ + (size_t)(tid + 512) * 8);                   \
  }
#define A_LOADV(T, RV)                                                              \
  if ((T) <= 128) {                                                                 \
    const u16* vs_ = (T) == 128 ? Vmeta : Vg + (size_t)(T) * 4096;                  \
    RV = *(const u32x4*)(vs_ + (size_t)tid * 8);                                    \
  }
#define A_WRITEK(DST, RK0, RK1) { *(u32x4*)((DST) + kw0) = RK0; if (k2) *(u32x4*)((DST) + kw1) = RK1; }
#define A_WRITEV(DST, RV) { *(u32x4*)((DST) + vw) = RV; }
#define A_QK(S, KB, MREF)                                                           \
  {                                                                                 \
    MREF = mrun;                                                                    \
    _Pragma("unroll") for (int s = 0; s < 6; ++s) {                                 \
      const int co_ = (((2 * s + hh) ^ ksw) << 4);                                  \
      const bf16x8 a0_ = *(const bf16x8*)((KB) + kr0 + co_);                        \
      const bf16x8 a1_ = *(const bf16x8*)((KB) + kr1 + co_);                        \
      if (s == 0) {                                                                 \
        S[0] = MFMA32(a0_, qf[s], negm);                                            \
        S[1] = MFMA32(a1_, qf[s], negm);                                            \
      } else {                                                                      \
        S[0] = MFMA32(a0_, qf[s], S[0]);                                            \
        S[1] = MFMA32(a1_, qf[s], S[1]);                                            \
      }                                                                             \
    }                                                                               \
  }
#define A_SOFTMAX_PV(S, VB, MASKED, MREF, FIRST)                                    \
  {                                                                                 \
    if (MASKED) {                                                                   \
      _Pragma("unroll") for (int i = 0; i < 16; ++i) { if (i >= 8) S[0][i] = -INFINITY; S[1][i] = -INFINITY; }  \
    }                                                                               \
    float mx_ = S[0][0];                                                            \
    _Pragma("unroll") for (int i = 1; i < 16; ++i) mx_ = fmaxf(mx_, S[0][i]);       \
    _Pragma("unroll") for (int i = 0; i < 16; ++i) mx_ = fmaxf(mx_, S[1][i]);       \
    mx_ = fmaxf(mx_, __shfl_xor(mx_, 32));                                          \
    const float d_ = MREF - mrun;                                                   \
    const float cand_ = mx_ + d_;                                                   \
    const bool upd_ = (FIRST) || cand_ > 8.f;                                       \
    if (__builtin_amdgcn_ballot_w64(upd_ || d_ != 0.f) != 0) {                      \
      const float mnew_ = upd_ ? mrun + cand_ : mrun;                               \
      const float shift_ = MREF - mnew_;                                            \
      const float alpha_ = (FIRST) ? 1.f : __builtin_amdgcn_exp2f(mrun - mnew_);    \
      mrun = mnew_;                                                                 \
      _Pragma("unroll") for (int i = 0; i < 16; ++i) {                              \
        O[0][i] *= alpha_; O[1][i] *= alpha_;                                       \
        S[0][i] += shift_; S[1][i] += shift_;                                       \
      }                                                                             \
      lrun *= alpha_;                                                               \
      _Pragma("unroll") for (int i = 0; i < 16; ++i) negm[i] = -mnew_;              \
    }                                                                               \
    _Pragma("unroll") for (int sp = 0; sp < 4; ++sp) {                              \
      const int mb = sp >> 1, t_ = sp & 1;                                          \
      u32x4 pf_;                                                                    \
      float e_[8];                                                                  \
      _Pragma("unroll") for (int q = 0; q < 8; ++q) { e_[q] = __builtin_amdgcn_exp2f(S[mb][8 * t_ + q]); lrun += e_[q]; }  \
      pf_[0] = pack2(e_[0], e_[1]); pf_[1] = pack2(e_[2], e_[3]);                   \
      pf_[2] = pack2(e_[4], e_[5]); pf_[3] = pack2(e_[6], e_[7]);                   \
      const int co_ = (((2 * sp + hh) ^ vsw) << 4);                                 \
      const bf16x8 v0_ = *(const bf16x8*)((VB) + vr0 + co_);                        \
      const bf16x8 v1_ = *(const bf16x8*)((VB) + vr1 + co_);                        \
      const bf16x8 pb_ = __builtin_bit_cast(bf16x8, pf_);                           \
      O[0] = MFMA32(v0_, pb_, O[0]);                                                \
      O[1] = MFMA32(v1_, pb_, O[1]);                                                \
    }                                                                               \
  }
#define A_STEP(J, SCUR, MCUR, SNEXT, MNEXT, KW, VW, KR, VR, RK0, RK1, RV)           \
  {                                                                                 \
    A_WRITEK(KW, RK0, RK1)                                                          \
    A_LOADK((J) + 3, RK0, RK1)                                                      \
    __builtin_amdgcn_sched_barrier(0);                                              \
    __builtin_amdgcn_s_setprio(1);                                                  \
    A_QK(SNEXT, KR, MNEXT)                                                          \
    __builtin_amdgcn_s_setprio(0);                                                  \
    RAW_BARRIER();                                                                  \
    A_WRITEV(VW, RV)                                                                \
    A_LOADV((J) + 2, RV)                                                            \
    __builtin_amdgcn_sched_barrier(0);                                              \
    A_SOFTMAX_PV(SCUR, VR, false, MCUR, (J) == 0)                                   \
    RAW_BARRIER();                                                                  \
  }
    __syncthreads();
    A_LOADK(0, rk0, rk1) A_LOADV(0, rv)
    A_WRITEK(sK0, rk0, rk1) A_WRITEV(sV0, rv)
    A_LOADK(1, rk0, rk1)
    A_WRITEK(sK1, rk0, rk1)
    A_LOADK(2, rk0, rk1) A_LOADV(1, rv)
    __syncthreads();
    f32x16 SA[2], SB[2];
    float mrefA, mrefB;
    A_QK(SA, sK0, mrefA)
    RAW_BARRIER();
    if (grp == 1) __builtin_amdgcn_s_barrier();
    for (int j = 0; j < 128; j += 2) {
      A_STEP(j, SA, mrefA, SB, mrefB, sK0, sV1, sK1, sV0, rk0, rk1, rv)
      A_STEP(j + 1, SB, mrefB, SA, mrefA, sK1, sV0, sK0, sV1, rk0, rk1, rv)
    }
    RAW_BARRIER();
    A_SOFTMAX_PV(SA, sV0, true, mrefA, false)
    if (grp == 0) RAW_BARRIER();
#undef A_LOADK
#undef A_LOADV
#undef A_WRITEK
#undef A_WRITEV
#undef A_QK
#undef A_SOFTMAX_PV
#undef A_STEP
    lrun += __shfl_xor(lrun, 32);
    const float inv = 1.f / lrun;
    u16* dst = AO + (size_t)qrow * 512 + h * 64;
#pragma unroll
    for (int dvb = 0; dvb < 2; ++dvb)
#pragma unroll
      for (int g4 = 0; g4 < 4; ++g4) {
        u32x2 o = {pack2(O[dvb][4 * g4] * inv, O[dvb][4 * g4 + 1] * inv), pack2(O[dvb][4 * g4 + 2] * inv, O[dvb][4 * g4 + 3] * inv)};
        *(u32x2*)(dst + dvb * 32 + 8 * g4 + 4 * hh) = o;
      }
  }
}

DI void phase_merge(const Params& p, char* smem) {
  char* ws = p.ws;
  const u16* YR = (const u16*)(ws + OFF_RG);
  const u16* AO = (const u16*)(ws + OFF_AO);
  const u16* GRET = (const u16*)(ws + OFF_GRET);
  const u16* GMLA = (const u16*)(ws + OFF_GMLA);
  const u16* WRET = (const u16*)(ws + OFF_WRET);
  const u16* WMLA = (const u16*)(ws + OFF_WMLA);
  u16* MG = (u16*)(ws + OFF_MG);
  for (int t = vbid(); t < 128 * 4; t += gridDim.x) {
    int mt, nt;
    tile_map(t, 128, 4, mt, nt);
    const int m0 = mt * 256, n0 = nt * 256;
    f32x16 acc[2][4];
#pragma unroll
    for (int mi = 0; mi < 2; ++mi)
#pragma unroll
      for (int ni = 0; ni < 4; ++ni) zero_acc(acc[mi][ni]);
    gemm8<false>(YR + (size_t)m0 * 1024, 1024, WRET + (size_t)n0 * 1024, 1024, 1024, acc, smem);
    __builtin_amdgcn_sched_barrier(0);
    {
      const int tid = otid(), lane = tid & 63, wave = tid >> 6;
      const size_t gbase = ((size_t)((m0 + (wave >> 1) * 64) >> 6) * 32 + ((n0 + (wave & 1) * 128) >> 5)) * 2;
#pragma unroll
      for (int mi = 0; mi < 2; ++mi)
#pragma unroll
        for (int np = 0; np < 2; ++np) {
#pragma unroll
          for (int nq = 0; nq < 2; ++nq) {
            const int ni = 2 * np + nq;
            const size_t go = ((gbase + (size_t)ni * 2 + mi) * 64 + lane) * 16;
            const u32x4 g0 = *(const u32x4*)(GRET + go), g1 = *(const u32x4*)(GRET + go + 8);
            const u32x4 h0 = *(const u32x4*)(GMLA + go), h1 = *(const u32x4*)(GMLA + go + 8);
#pragma unroll
            for (int i = 0; i < 16; ++i) {
              const unsigned gu = i < 8 ? g0[i >> 1] : g1[(i - 8) >> 1];
              const unsigned hu = i < 8 ? h0[i >> 1] : h1[(i - 8) >> 1];
              const float gr = (i & 1) ? bfhi(gu) : bflo(gu);
              const float gm = fmaxf((i & 1) ? bfhi(hu) : bflo(hu), 1e-20f);
              acc[mi][ni][i] *= gr * __builtin_amdgcn_rcpf(gm);
            }
          }
          __builtin_amdgcn_sched_barrier(0);
        }
    }
    gemm_core<4>(AO + (size_t)m0 * 512, 512, WMLA + (size_t)n0 * 512, 512, 512, acc, smem);
    __builtin_amdgcn_sched_barrier(0);
    {
      const int tid = otid(), lane = tid & 63, wave = tid >> 6;
      const int wm = wave >> 1, wn = wave & 1, r = lane & 31, hh = lane >> 5;
      const size_t gbase = ((size_t)((m0 + wm * 64) >> 6) * 32 + ((n0 + wn * 128) >> 5)) * 2;
#pragma unroll
      for (int mi = 0; mi < 2; ++mi)
#pragma unroll
        for (int np = 0; np < 2; ++np) {
#pragma unroll
          for (int nq = 0; nq < 2; ++nq) {
            const int ni = 2 * np + nq;
            const size_t go = ((gbase + (size_t)ni * 2 + mi) * 64 + lane) * 16;
            const u32x4 h0 = *(const u32x4*)(GMLA + go), h1 = *(const u32x4*)(GMLA + go + 8);
            u16* mrow = MG + (size_t)(m0 + wm * 64 + mi * 32 + 4 * hh) * 1024 + n0 + wn * 128 + ni * 32 + r;
#pragma unroll
            for (int i = 0; i < 16; ++i) {
              const unsigned hu = i < 8 ? h0[i >> 1] : h1[(i - 8) >> 1];
              const float gm = fmaxf((i & 1) ? bfhi(hu) : bflo(hu), 1e-20f);
              mrow[(size_t)((i & 3) + 8 * (i >> 2)) * 1024] = f2bf(gm * acc[mi][ni][i]);
            }
          }
          __builtin_amdgcn_sched_barrier(0);
        }
    }
  }
}

DI void phase_wo(const Params& p, char* smem) {
  char* ws = p.ws;
  const u16* MG = (const u16*)(ws + OFF_MG);
  const u16* WO = (const u16*)(ws + OFF_WO);
  u16* H1B = (u16*)(ws + OFF_H1B);
  float* SS1 = (float*)(ws + OFF_SS1);
  const int tid = otid(), lane = tid & 63, wave = tid >> 6;
  const int wm = wave >> 1, wn = wave & 1, r = lane & 31, hh = lane >> 5;
  bool staged = false;
  for (int t = vbid(); t < 128 * 4; t += gridDim.x) {
    int mt, nt;
    tile_map(t, 128, 4, mt, nt);
    const int m0 = mt * 256, n0 = nt * 256;
    const u16 *nA = nullptr, *nB = nullptr;
    if (t + (int)gridDim.x < 128 * 4) {
      int mt2, nt2;
      tile_map(t + gridDim.x, 128, 4, mt2, nt2);
      nA = MG + (size_t)mt2 * 256 * 1024; nB = WO + (size_t)nt2 * 256 * 1024;
    }
    f32x16 acc[2][4];
#pragma unroll
    for (int mi = 0; mi < 2; ++mi)
#pragma unroll
      for (int ni = 0; ni < 4; ++ni) zero_acc(acc[mi][ni]);
    gemm8<false>(MG + (size_t)m0 * 1024, 1024, WO + (size_t)n0 * 1024, 1024, 1024, acc, smem);
    const int col0 = n0 + wn * 128;
#pragma unroll
    for (int mi = 0; mi < 2; ++mi) {
#pragma unroll
      for (int i = 0; i < 16; ++i) {
        const int row = m0 + wm * 64 + mi * 32 + crow(i, hh);
#pragma unroll
        for (int ni = 0; ni < 4; ++ni) {
          const size_t o = (size_t)row * 1024 + col0 + ni * 32 + r;
          const float v = p.x[o] + acc[mi][ni][i];
          acc[mi][ni][i] = v;
          H1B[o] = f2bf(v);
        }
      }
      __builtin_amdgcn_sched_barrier(0);
    }
    rowss_partial<4>(acc, smem, SS1, 8, col0 >> 7, m0, true);
  }
}

DI void phase_gu(const Params& p, char* smem) {
  char* ws = p.ws;
  const u16* H1B = (const u16*)(ws + OFF_H1B);
  const u16* WGU = (const u16*)(ws + OFF_WGU);
  const float* SS1 = (const float*)(ws + OFF_SS1);
  u16* ACT = (u16*)(ws + OFF_ACT);
  float* sRS = (float*)(smem + 133120);
  const int tid = otid(), lane = tid & 63, wave = tid >> 6;
  const int wm = wave >> 1, wn = wave & 1, r = lane & 31, hh = lane >> 5;
  constexpr int NT = 5632 / 256;
  bool staged = false;
  for (int t = vbid(); t < 128 * NT; t += gridDim.x) {
    int mt, nt;
    tile_map(t, 128, NT, mt, nt);
    const int m0 = mt * 256, n0 = nt * 256;
    const u16 *nA = nullptr, *nB = nullptr;
    if (t + (int)gridDim.x < 128 * NT) {
      int mt2, nt2;
      tile_map(t + gridDim.x, 128, NT, mt2, nt2);
      nA = H1B + (size_t)mt2 * 256 * 1024; nB = WGU + (size_t)nt2 * 256 * 1024;
    }
    RAW_BARRIER();
    if (tid < 256) {
      const float4 a = *(const float4*)(SS1 + (size_t)(m0 + tid) * 8), b = *(const float4*)(SS1 + (size_t)(m0 + tid) * 8 + 4);
      sRS[tid] = rsqrtf((a.x + a.y + a.z + a.w + b.x + b.y + b.z + b.w) * (1.f / 1024.f) + 1e-6f);
    }
    f32x16 acc[2][4];
#pragma unroll
    for (int mi = 0; mi < 2; ++mi)
#pragma unroll
      for (int ni = 0; ni < 4; ++ni) zero_acc(acc[mi][ni]);
    gemm8<true>(H1B + (size_t)m0 * 1024, 1024, WGU + (size_t)n0 * 1024, 1024, 1024, acc, smem);
    const int col0 = n0 + wn * 128;
#pragma unroll
    for (int mi = 0; mi < 2; ++mi) {
      const int rl = wm * 64 + mi * 32 + r;
      const float rs = sRS[rl];
      u16* arow = ACT + (size_t)(m0 + rl) * DFF + (col0 >> 1);
#pragma unroll
      for (int gi = 0; gi < 2; ++gi) {
        float v[16];
#pragma unroll
        for (int i = 0; i < 16; ++i) v[i] = siluf_(acc[mi][2 * gi][i] * rs) * (acc[mi][2 * gi + 1][i] * rs);
        store_block32(arow + gi * 32, v, hh);
      }
    }
  }
}

DI void phase_down(const Params& p, char* smem) {
  char* ws = p.ws;
  const u16* ACT = (const u16*)(ws + OFF_ACT);
  const u16* WD = (const u16*)(ws + OFF_WD);
  const u16* H1B = (const u16*)(ws + OFF_H1B);
  const int tid = otid(), lane = tid & 63, wave = tid >> 6;
  const int wm = wave >> 1, wn = wave & 1, r = lane & 31, hh = lane >> 5;
  bool staged = false;
  for (int t = vbid(); t < 128 * 4; t += gridDim.x) {
    int mt, nt;
    tile_map(t, 128, 4, mt, nt);
    const int m0 = mt * 256, n0 = nt * 256;
    const u16 *nA = nullptr, *nB = nullptr;
    if (t + (int)gridDim.x < 128 * 4) {
      int mt2, nt2;
      tile_map(t + gridDim.x, 128, 4, mt2, nt2);
      nA = ACT + (size_t)mt2 * 256 * DFF; nB = WD + (size_t)nt2 * 256 * DFF;
    }
    f32x16 acc[2][4];
#pragma unroll
    for (int mi = 0; mi < 2; ++mi)
#pragma unroll
      for (int ni = 0; ni < 4; ++ni) zero_acc(acc[mi][ni]);
    gemm8<false>(ACT + (size_t)m0 * DFF, DFF, WD + (size_t)n0 * DFF, DFF, DFF, acc, smem);
    const int col0 = n0 + wn * 128;
#pragma unroll
    for (int mi = 0; mi < 2; ++mi) {
#pragma unroll
      for (int i = 0; i < 16; ++i) {
        const int row = m0 + wm * 64 + mi * 32 + crow(i, hh);
#pragma unroll
        for (int ni = 0; ni < 4; ++ni) {
          const size_t o = (size_t)row * 1024 + col0 + ni * 32 + r;
          p.out[o] = bf2f(H1B[o]) + acc[mi][ni][i];
        }
      }
      __builtin_amdgcn_sched_barrier(0);
    }
  }
}

DI void phase_final(const Params& p) {
  const int gtid = blockIdx.x * NTHR + threadIdx.x, gthreads = gridDim.x * NTHR;
  const int lane = threadIdx.x & 63;
  const int gwave = gtid >> 6, nwaves = gthreads >> 6;
  float4 w[4];
#pragma unroll
  for (int q = 0; q < 4; ++q) w[q] = *(const float4*)(p.norm_final_w + q * 256 + lane * 4);
  for (int row0 = gwave * 4; row0 < M; row0 += nwaves * 4) {
    float4 v[4][4];
#pragma unroll
    for (int k = 0; k < 4; ++k)
#pragma unroll
      for (int q = 0; q < 4; ++q) v[k][q] = *(const float4*)(p.out + (size_t)(row0 + k) * 1024 + q * 256 + lane * 4);
#pragma unroll
    for (int k = 0; k < 4; ++k) {
      float ss = 0.f;
#pragma unroll
      for (int q = 0; q < 4; ++q) ss += v[k][q].x * v[k][q].x + v[k][q].y * v[k][q].y + v[k][q].z * v[k][q].z + v[k][q].w * v[k][q].w;
      ss = wave_sum(ss);
      const float rs = rsqrtf(ss * (1.f / 1024.f) + 1e-6f);
#pragma unroll
      for (int q = 0; q < 4; ++q) {
        float4 o = make_float4(v[k][q].x * rs * w[q].x, v[k][q].y * rs * w[q].y, v[k][q].z * rs * w[q].z, v[k][q].w * rs * w[q].w);
        *(float4*)(p.out + (size_t)(row0 + k) * 1024 + q * 256 + lane * 4) = o;
      }
    }
  }
}

#define XB_TMO      128
#define XB_XCNT(j)  (256  + 64 * (j))
#define XB_XSUB(j)  (1280 + 64 * (j))
#define XB_XGEN(j)  (2304 + 64 * (j))
#define XB_TOP      3328
#define XB_TOPGEN   3392
#define XCD_BAR_WORDS 3456
#define XB_SPIN_CAP (1u << 18)
#define LAS __attribute__((address_space(3)))

DI unsigned xb_ld(unsigned* p)              { return __hip_atomic_load(p, __ATOMIC_RELAXED, __HIP_MEMORY_SCOPE_AGENT); }
DI unsigned xb_add(unsigned* p, unsigned v) { return __hip_atomic_fetch_add(p, v, __ATOMIC_RELAXED, __HIP_MEMORY_SCOPE_AGENT); }
DI unsigned xb_xcc_id() { return (unsigned)__builtin_amdgcn_s_getreg((3 << 11) | 20) & 0xFu; }
#define XB_SPIN(cond, bar) do { unsigned _sp = 0; while (cond) { __builtin_amdgcn_s_sleep(1); \
    if ((++_sp & 255u) == 0u) { if (xb_ld(&(bar)[XB_TMO])) break; if (_sp > XB_SPIN_CAP) { atomicAdd(&(bar)[XB_TMO], 1u); break; } } } } while (0)

struct XcdBarrier {
    unsigned* bar; unsigned x;
    volatile LAS unsigned* st;
};

DI XcdBarrier xcd_barrier_post(unsigned* bar, volatile LAS unsigned* st) {
    XcdBarrier b; b.bar = bar; b.x = xb_xcc_id(); b.st = st;
    if (threadIdx.x == 0) (void)xb_add(&bar[XB_XCNT(b.x)], 1u);
    return b;
}
DI void xcd_barrier_complete(unsigned* bar, unsigned x, unsigned& nloc, unsigned& nx) {
    const unsigned G = gridDim.x * gridDim.y * gridDim.z;
    unsigned sum, cnt, mine, sp = 0u;
    for (;;) {
        sum = 0u; cnt = 0u; mine = 0u;
#pragma unroll
        for (unsigned j = 0; j < 16; ++j) { const unsigned c = xb_ld(&bar[XB_XCNT(j)]); sum += c; cnt += (c > 0u) ? 1u : 0u; mine = (j == x) ? c : mine; }
        if (sum == G) break;
        __builtin_amdgcn_s_sleep(1);
        if ((++sp & 255u) == 0u) { if (xb_ld(&bar[XB_TMO])) break; if (sp > XB_SPIN_CAP) { atomicAdd(&bar[XB_TMO], 1u); break; } }
    }
    nloc = mine > 0u ? mine : 1u; nx = cnt > 0u ? cnt : 1u;
}

DI void xcd_barrier(const XcdBarrier& b) {
    asm volatile("s_waitcnt vmcnt(0)" ::: "memory");
    __syncthreads();
    if (threadIdx.x == 0) {
        unsigned* bar = b.bar;
        __builtin_amdgcn_s_waitcnt(0);
        unsigned nloc = b.st[0], nx = b.st[1];
        if (nloc == 0u) { xcd_barrier_complete(bar, b.x, nloc, nx); b.st[0] = nloc; b.st[1] = nx; }
        const unsigned old = xb_add(&bar[XB_XSUB(b.x)], 1u);
        const unsigned gen = old / nloc;
        if (old + 1u == (gen + 1u) * nloc) {
            __builtin_amdgcn_fence(__ATOMIC_RELEASE, "agent");
            asm volatile("s_waitcnt vmcnt(0)" ::: "memory");
            const unsigned og = xb_add(&bar[XB_TOP], 1u);
            const unsigned tg = og / nx;
            if (og + 1u == (tg + 1u) * nx) xb_add(&bar[XB_TOPGEN], 1u);
            else XB_SPIN(xb_ld(&bar[XB_TOPGEN]) == tg, bar);
            __builtin_amdgcn_fence(__ATOMIC_ACQUIRE, "agent");
            xb_add(&bar[XB_XGEN(b.x)], 1u);
            asm volatile("s_waitcnt vmcnt(0)" ::: "memory");
        } else {
            XB_SPIN(xb_ld(&bar[XB_XGEN(b.x)]) == gen, bar);
            __builtin_amdgcn_fence(__ATOMIC_ACQUIRE, "agent");
            asm volatile("s_waitcnt vmcnt(0)" ::: "memory");
        }
    }
    __syncthreads();
}

DI void grid_barrier(unsigned* ctr, unsigned target) {
  asm volatile("s_waitcnt vmcnt(0)" ::: "memory");
  __syncthreads();
  if (threadIdx.x == 0) {
    __builtin_amdgcn_fence(__ATOMIC_RELEASE, "agent");
    asm volatile("s_waitcnt vmcnt(0)" ::: "memory");
    __hip_atomic_fetch_add(ctr, 1u, __ATOMIC_RELAXED, __HIP_MEMORY_SCOPE_AGENT);
    while (__hip_atomic_load(ctr, __ATOMIC_RELAXED, __HIP_MEMORY_SCOPE_AGENT) < target) __builtin_amdgcn_s_sleep(2);
    __builtin_amdgcn_fence(__ATOMIC_ACQUIRE, "agent");
    asm volatile("s_waitcnt vmcnt(0)" ::: "memory");
  }
  __syncthreads();
}

constexpr int NPHASE = 12;

#if MULTI_LAUNCH
#define PH_ARGS , int ph_lo, int ph_hi
#define RUN_PHASE(k, call) if (ph_lo <= (k) && (k) < ph_hi) { call; }
#else
#define PH_ARGS
#define RUN_PHASE(k, call) { call; if ((k) + 1 < NPHASE) { XcdBarrier b_; b_.bar = (unsigned*)(p.ws + OFF_BAR); b_.x = xb_xcc_id(); b_.st = (volatile LAS unsigned*)&xb_words; xcd_barrier(b_); } }
#endif

__global__ void __launch_bounds__(512, 2) mega(Params p PH_ARGS) {
  __shared__ __attribute__((aligned(16))) char smem[134144];
  __shared__ uint4 xb_words;
  if (threadIdx.x == 0) xb_words = make_uint4(0u, 0u, 0u, 0u);
  __syncthreads();
  if (p.ws == nullptr) cg::this_grid().sync();
  (void)xcd_barrier_post((unsigned*)(p.ws + OFF_BAR), (volatile LAS unsigned*)&xb_words);
  RUN_PHASE(0, phase_prep(p, smem))
  RUN_PHASE(1, phase_proj(p, smem))
  RUN_PHASE(2, phase_ret_incr(p, smem))
  RUN_PHASE(3, phase_ret_scan(p))
  RUN_PHASE(4, phase_ret_out(p, smem))
  RUN_PHASE(5, phase_mla_proj(p, smem))
  RUN_PHASE(6, phase_attn(p, smem))
  RUN_PHASE(7, phase_merge(p, smem))
  RUN_PHASE(8, phase_wo(p, smem))
  RUN_PHASE(9, phase_gu(p, smem))
  RUN_PHASE(10, phase_down(p, smem))
  RUN_PHASE(11, phase_final(p))
}

extern "C" void kernel_launch(void* const* d_in, const int* in_sizes, int n_in, void* d_out, int out_size,
                              void* d_ws, size_t ws_size, hipStream_t stream) {
  static int grid_blocks = 0;
  if (!grid_blocks) {
    int dev = 0, cus = 0, per_cu = 0;
    hipGetDevice(&dev);
    hipDeviceGetAttribute(&cus, hipDeviceAttributeMultiprocessorCount, dev);
    hipOccupancyMaxActiveBlocksPerMultiprocessor(&per_cu, mega, NTHR, 0);
    if (per_cu > 1) per_cu = 1;
    if (per_cu < 1) per_cu = 1;
    grid_blocks = cus * per_cu;
  }
  Params p{};
  p.x = (const float*)d_in[0]; p.meta = (const float*)d_in[1]; p.norm_mix_w = (const float*)d_in[2];
  p.w_in = (const float*)d_in[3]; p.decay_f = (const float*)d_in[4]; p.decay_b = (const float*)d_in[5];
  p.gn_w = (const float*)d_in[6]; p.w_ret_out = (const float*)d_in[7]; p.q_norm_w = (const float*)d_in[8];
  p.w_uq = (const float*)d_in[9]; p.kv_norm_w = (const float*)d_in[10]; p.w_uk = (const float*)d_in[11];
  p.w_uv = (const float*)d_in[12]; p.w_mla_out = (const float*)d_in[13]; p.w_o = (const float*)d_in[14];
  p.norm_ffn_w = (const float*)d_in[15]; p.w_gate = (const float*)d_in[16]; p.w_up = (const float*)d_in[17];
  p.w_down = (const float*)d_in[18]; p.norm_final_w = (const float*)d_in[19];
  p.out = (float*)d_out;
  p.ws = (char*)d_ws;
  if (ws_size < WS_END) { fprintf(stderr, "workspace too small: %zu < %zu\n", ws_size, (size_t)WS_END); return; }
#if MULTI_LAUNCH
  for (int ph = 0; ph < NPHASE; ++ph) hipLaunchKernelGGL(mega, dim3(grid_blocks), dim3(NTHR), 0, stream, p, ph, ph + 1);
#else
  hipMemsetAsync((char*)d_ws + OFF_BAR, 0, 16384, stream);
  void* args[] = {&p};
  hipError_t e = hipLaunchCooperativeKernel((void*)mega, dim3(grid_blocks), dim3(NTHR), args, 0, stream);
  if (e != hipSuccess) fprintf(stderr, "cooperative launch failed: %s (grid %d)\n", hipGetErrorString(e), grid_blocks);
#endif
}
```

```cpp
#include <hip/hip_runtime.h>
#include <hip/hip_cooperative_groups.h>
#include <stdint.h>
#include <cstdio>
namespace cg = cooperative_groups;

#ifndef MULTI_LAUNCH
#define MULTI_LAUNCH 0
#endif

typedef unsigned short u16;
typedef __attribute__((ext_vector_type(8))) short bf16x8;
typedef __attribute__((ext_vector_type(16))) float f32x16;
typedef __attribute__((ext_vector_type(4))) unsigned u32x4;
typedef __attribute__((ext_vector_type(2))) unsigned u32x2;
typedef __attribute__((ext_vector_type(2))) float f32x2;
typedef __attribute__((ext_vector_type(2))) __bf16 bf16x2v;

#define DI __device__ __forceinline__
#define MFMA32(a, b, c) __builtin_amdgcn_mfma_f32_32x32x16_bf16((a), (b), (c), 0, 0, 0)

constexpr int M = 32768;
constexpr int MT = 33024;
constexpr int NTHR = 512;
constexpr int SEQ = 8192;
constexpr int NPOS = 8208;
constexpr int DFF = 2816;
constexpr int NIN = 5888;

constexpr size_t SZ_WIN = (size_t)NIN * 1024 * 2;
constexpr size_t OFF_WIN = 0;
constexpr size_t OFF_WRET = OFF_WIN + SZ_WIN;
constexpr size_t OFF_WUQ = OFF_WRET + 1024 * 1024 * 2;
constexpr size_t OFF_WUKV = OFF_WUQ + 768 * 384 * 2;
constexpr size_t OFF_WMLA = OFF_WUKV + 1024 * 256 * 2;
constexpr size_t OFF_WO = OFF_WMLA + 1024 * 512 * 2;
constexpr size_t OFF_WGU = OFF_WO + 1024 * 1024 * 2;
constexpr size_t OFF_WD = OFF_WGU + (size_t)5632 * 1024 * 2;
constexpr size_t OFF_TRET = OFF_WD + (size_t)1024 * DFF * 2;
constexpr size_t OFF_TMLA = OFF_TRET + (size_t)NPOS * 32 * 8;
constexpr size_t OFF_R1 = OFF_TMLA + (size_t)NPOS * 16 * 8;
constexpr size_t SZ_U = (size_t)MT * 1024 * 2;
constexpr size_t OFF_RQ = OFF_R1 + SZ_U;
constexpr size_t OFF_RK = OFF_RQ + (size_t)M * 512 * 2;
constexpr size_t OFF_RKT = OFF_RK + (size_t)M * 512 * 2;
constexpr size_t OFF_RVT = OFF_RKT + (size_t)512 * MT * 2;
constexpr size_t OFF_RG = OFF_RVT + (size_t)1024 * MT * 2;
constexpr size_t OFF_CQ = OFF_RG + (size_t)M * 1024 * 2;
constexpr size_t OFF_CKV = OFF_CQ + (size_t)MT * 384 * 2;
constexpr size_t OFF_KR = OFF_CKV + (size_t)MT * 256 * 2;
constexpr size_t OFF_SSQ = OFF_KR + (size_t)MT * 32 * 2;
constexpr size_t OFF_SSKV = OFF_SSQ + (size_t)MT * 4 * 4;
constexpr size_t OFF_GRET = OFF_SSKV + (size_t)MT * 4 * 4;
constexpr size_t OFF_GMLA = OFF_GRET + (size_t)M * 1024 * 2;
constexpr size_t OFF_BAR = OFF_GMLA + (size_t)M * 1024 * 2;
constexpr size_t WS_END = OFF_BAR + 16384;
constexpr size_t OFF_INCR = OFF_R1;
constexpr size_t OFF_Q = OFF_R1;
constexpr size_t OFF_K = OFF_Q + (size_t)M * 768 * 2;
constexpr size_t OFF_VT = OFF_K + (size_t)32 * SEQ * 96 * 2;
constexpr size_t OFF_KM = OFF_VT + (size_t)32 * 64 * SEQ * 2;
constexpr size_t OFF_VM = OFF_KM + (size_t)8 * 64 * 96 * 2;
constexpr size_t OFF_AO = OFF_VM + (size_t)8 * 64 * 64 * 2;
constexpr size_t OFF_MG = OFF_R1;
constexpr size_t OFF_H1B = OFF_RG;
constexpr size_t OFF_SS1 = OFF_CQ;
constexpr size_t OFF_ACT = OFF_R1;
static_assert(OFF_AO + (size_t)M * 512 * 2 <= OFF_RG, "alias overflow");
static_assert(OFF_ACT + (size_t)M * DFF * 2 <= OFF_RG, "alias overflow");

struct Params {
  const float *x, *meta, *norm_mix_w, *w_in, *decay_f, *decay_b, *gn_w, *w_ret_out, *q_norm_w, *w_uq,
      *kv_norm_w, *w_uk, *w_uv, *w_mla_out, *w_o, *norm_ffn_w, *w_gate, *w_up, *w_down, *norm_final_w;
  float* out;
  char* ws;
};

DI unsigned pack2(float a, float b) {
  f32x2 v = {a, b};
  return __builtin_bit_cast(unsigned, __builtin_convertvector(v, bf16x2v));
}
DI u16 f2bf(float a) { return (u16)(pack2(a, 0.f) & 0xffffu); }
DI float bflo(unsigned u) { return __uint_as_float(u << 16); }
DI float bfhi(unsigned u) { return __uint_as_float(u & 0xffff0000u); }
DI float bf2f(u16 v) { return __uint_as_float(((unsigned)v) << 16); }
DI int otid() { int t = threadIdx.x; asm volatile("" : "+v"(t)); return t; }
DI int crow(int i, int hh) { return (i & 3) + 8 * (i >> 2) + 4 * hh; }
DI float sigmoidf_(float x) { return __builtin_amdgcn_rcpf(1.f + __builtin_amdgcn_exp2f(x * -1.4426950408889634f)); }
DI float siluf_(float x) { return x * __builtin_amdgcn_rcpf(1.f + __builtin_amdgcn_exp2f(x * -1.4426950408889634f)); }
DI float wave_sum(float v) {
#pragma unroll
  for (int o = 32; o > 0; o >>= 1) v += __shfl_xor(v, o);
  return v;
}
DI int row_pos(int row) {
  int p = row < M ? (row & (SEQ - 1)) + 16 : row - M;
  return p < NPOS ? p : NPOS - 1;
}
typedef __attribute__((ext_vector_type(2))) unsigned u32x2s;
DI void store_block32(u16* rowptr, const float (&v)[16], int hh) {
  unsigned a0 = pack2(v[0], v[1]), a1 = pack2(v[2], v[3]);
  unsigned b0 = pack2(v[4], v[5]), b1 = pack2(v[6], v[7]);
  unsigned c0 = pack2(v[8], v[9]), c1 = pack2(v[10], v[11]);
  unsigned d0 = pack2(v[12], v[13]), d1 = pack2(v[14], v[15]);
  u32x2s t;
  t = __builtin_amdgcn_permlane32_swap(a0, b0, false, false); a0 = t[0]; b0 = t[1];
  t = __builtin_amdgcn_permlane32_swap(a1, b1, false, false); a1 = t[0]; b1 = t[1];
  t = __builtin_amdgcn_permlane32_swap(c0, d0, false, false); c0 = t[0]; d0 = t[1];
  t = __builtin_amdgcn_permlane32_swap(c1, d1, false, false); c1 = t[0]; d1 = t[1];
  u32x4 lo = {a0, a1, b0, b1}, hi = {c0, c1, d0, d1};
  *(u32x4*)(rowptr + 8 * hh) = lo;
  *(u32x4*)(rowptr + 16 + 8 * hh) = hi;
}
DI void store_tokblk(u16* base, int fstride, const float (&v)[16], int hh) {
  unsigned a0 = pack2(v[0], v[1]), a1 = pack2(v[2], v[3]);
  unsigned b0 = pack2(v[4], v[5]), b1 = pack2(v[6], v[7]);
  unsigned c0 = pack2(v[8], v[9]), c1 = pack2(v[10], v[11]);
  unsigned d0 = pack2(v[12], v[13]), d1 = pack2(v[14], v[15]);
  u32x2s t;
  t = __builtin_amdgcn_permlane32_swap(a0, b0, false, false); a0 = t[0]; b0 = t[1];
  t = __builtin_amdgcn_permlane32_swap(a1, b1, false, false); a1 = t[0]; b1 = t[1];
  t = __builtin_amdgcn_permlane32_swap(c0, d0, false, false); c0 = t[0]; d0 = t[1];
  t = __builtin_amdgcn_permlane32_swap(c1, d1, false, false); c1 = t[0]; d1 = t[1];
  u32x4 lo = {a0, a1, b0, b1}, hi = {c0, c1, d0, d1};
  *(u32x4*)(base + (size_t)hh * fstride * 8) = lo;
  *(u32x4*)(base + (size_t)(2 + hh) * fstride * 8) = hi;
}
DI void zero_acc(f32x16& a) {
#pragma unroll
  for (int i = 0; i < 16; ++i) a[i] = 0.f;
}

DI int vbid() {
  const int G = gridDim.x;
  return (G & 7) ? (int)blockIdx.x : (int)(blockIdx.x & 7) * (G >> 3) + (int)(blockIdx.x >> 3);
}
DI bool tile_map(int seq, int mtiles, int NT, int& mt, int& nt) {
  const int panel = seq / (4 * NT), rem = seq - panel * 4 * NT;
  nt = rem >> 2;
  mt = panel * 4 + (rem & 3);
  return mt < mtiles;
}

typedef __attribute__((address_space(3))) void lds_void;
typedef const __attribute__((address_space(1))) void glb_void;
#define GLDS16(SRC, DST) __builtin_amdgcn_global_load_lds((glb_void*)(SRC), (lds_void*)(DST), 16, 0, 0)
#define WAIT_VM0() asm volatile("s_waitcnt vmcnt(0)" ::: "memory")
#define RAW_BARRIER() do { asm volatile("s_waitcnt lgkmcnt(0)" ::: "memory"); __builtin_amdgcn_s_barrier(); } while (0)
template <int NI, bool TR = false>
DI void gemm_core(const u16* __restrict__ A, int lda, const u16* __restrict__ Bt, int ldb, int K,
                  f32x16 (&acc)[2][NI], char* smem, bool staged = false, const u16* nA = nullptr, int nlda = 0,
                  const u16* nBt = nullptr, int nldb = 0) {
  constexpr int AB = 256 * 128;
  constexpr int BUF = AB + 64 * NI * 128;
  const int tid = otid(), lane = tid & 63, wave = tid >> 6;
  const int wm = wave >> 1, wn = wave & 1;
  const int r = lane & 31, hh = lane >> 5;
  const int lrow = tid >> 3, lc = tid & 7;
  const int rsw = (r >> 1) & 7;
  const u16* Ap = A + (size_t)lrow * lda + ((lc ^ ((lrow >> 1) & 7)) << 3);
  const u16* Bp = Bt + (size_t)lrow * ldb + ((lc ^ ((lrow >> 1) & 7)) << 3);
  char* lbase = smem + (wave << 10);
  const int nk = K >> 6;
  const int aoff = (wm * 64 + r) * 128, boff = AB + (wn * 32 * NI + r) * 128;
#define G_STAGE(ST, KT)                                                                             \
  {                                                                                                 \
    const int ko_ = (KT) * 64;                                                                      \
    char* d_ = lbase + (ST) * BUF;                                                                  \
    _Pragma("unroll") for (int p = 0; p < 4; ++p) GLDS16(Ap + (size_t)(64 * p) * lda + ko_, d_ + p * 8192);         \
    _Pragma("unroll") for (int p = 0; p < NI; ++p) GLDS16(Bp + (size_t)(64 * p) * ldb + ko_, d_ + AB + p * 8192);   \
  }
#define G_READ(FA, FB, S)                                                                           \
  {                                                                                                 \
    const int co_ = (((2 * (S) + hh) ^ rsw) << 4);                                                  \
    _Pragma("unroll") for (int mi = 0; mi < 2; ++mi) FA[mi] = *(const bf16x8*)(cur + aoff + mi * 4096 + co_);   \
    _Pragma("unroll") for (int ni = 0; ni < NI; ++ni) FB[ni] = *(const bf16x8*)(cur + boff + ni * 4096 + co_);  \
  }
#define G_MMA(FA, FB)                                                                               \
  {                                                                                                 \
    _Pragma("unroll") for (int mi = 0; mi < 2; ++mi)                                                \
      _Pragma("unroll") for (int ni = 0; ni < NI; ++ni)                                             \
        acc[mi][ni] = TR ? MFMA32(FB[ni], FA[mi], acc[mi][ni]) : MFMA32(FA[mi], FB[ni], acc[mi][ni]);           \
  }
  if (!staged) {
    __syncthreads();
    G_STAGE(0, 0)
  }
  WAIT_VM0();
  __syncthreads();
  for (int kt = 0; kt < nk; ++kt) {
    const char* cur = smem + (kt & 1) * BUF;
    bf16x8 fa0[2], fb0[NI], fa1[2], fb1[NI];
    if (kt + 1 < nk) G_STAGE((kt + 1) & 1, kt + 1)
    else if (nA) {
      const u16* nAp = nA + (size_t)lrow * nlda + ((lc ^ ((lrow >> 1) & 7)) << 3);
      const u16* nBp = nBt + (size_t)lrow * nldb + ((lc ^ ((lrow >> 1) & 7)) << 3);
      _Pragma("unroll") for (int p = 0; p < 4; ++p) GLDS16(nAp + (size_t)(64 * p) * nlda, lbase + p * 8192);
      _Pragma("unroll") for (int p = 0; p < NI; ++p) GLDS16(nBp + (size_t)(64 * p) * nldb, lbase + AB + p * 8192);
    }
    G_READ(fa0, fb0, 0)
    __builtin_amdgcn_sched_barrier(0);
    G_READ(fa1, fb1, 1)
    G_MMA(fa0, fb0)
    __builtin_amdgcn_sched_barrier(0);
    G_READ(fa0, fb0, 2)
    G_MMA(fa1, fb1)
    __builtin_amdgcn_sched_barrier(0);
    G_READ(fa1, fb1, 3)
    G_MMA(fa0, fb0)
    __builtin_amdgcn_sched_barrier(0);
    G_MMA(fa1, fb1)
    __builtin_amdgcn_sched_barrier(0);
    if (kt + 1 < nk) {
      WAIT_VM0();
      __syncthreads();
    } else {
      asm volatile("s_waitcnt lgkmcnt(0)" ::: "memory");
      __builtin_amdgcn_s_barrier();
    }
  }
#undef G_STAGE
#undef G_READ
#undef G_MMA
}

#define WAIT_V8(n) asm volatile("s_waitcnt vmcnt(" #n ")" ::: "memory")
#define WAIT_L8(n) asm volatile("s_waitcnt lgkmcnt(" #n ")" ::: "memory")
#define BAR8 __builtin_amdgcn_s_barrier()
#define SCHED8 __builtin_amdgcn_sched_barrier(0)
template <bool TR>
DI void gemm8(const u16* __restrict__ A, int lda, const u16* __restrict__ Bt, int ldb, int K,
              f32x16 (&acc)[2][4], char* smem) {
  const int tid = otid(), lane = tid & 63, wave = tid >> 6;
  const int r = lane & 31, hh = lane >> 5;
  const int grp = __builtin_amdgcn_readfirstlane(wave) >> 2;
  const int ir0 = wave * 8 + (lane >> 3), ir1 = ir0 + 64;
  const int csrc = ((lane & 7) ^ ((ir0 >> 1) & 7)) << 3;
  const unsigned vA0 = (unsigned)(((ir0 >> 5) * 64 + (ir0 & 31)) * lda + csrc) * 2u;
  const unsigned vA1 = (unsigned)(((ir1 >> 5) * 64 + (ir1 & 31)) * lda + csrc) * 2u;
  const unsigned vB0 = (unsigned)(((ir0 >> 6) * 128 + (ir0 & 63)) * ldb + csrc) * 2u;
  const unsigned vB1 = (unsigned)(((ir1 >> 6) * 128 + (ir1 & 63)) * ldb + csrc) * 2u;
  const int rsw = (r >> 1) & 7;
  typedef const __attribute__((address_space(3))) bf16x8 lds_frag;
  const unsigned sbase = (unsigned)(size_t)(lds_void*)smem;
  const unsigned lb = __builtin_amdgcn_readfirstlane(sbase + (wave << 10));
  unsigned aad[4], bad[4];
#pragma unroll
  for (int s = 0; s < 4; ++s) {
    aad[s] = sbase + ((wave >> 1) * 32 + r) * 128 + (((2 * s + hh) ^ rsw) << 4);
    bad[s] = sbase + 65536 + ((wave & 1) * 64 + r) * 128 + (((2 * s + hh) ^ rsw) << 4);
  }
#define SA8(b, h) (((b) * 2 + (h)) * 16384)
#define SB8(b, h) ((4 + (b) * 2 + (h)) * 16384)
#define STAGE_A8(b, h, kt)                                                                       \
  {                                                                                              \
    const char* sb_ = (const char*)A + ((size_t)((h) * 32) * lda + (size_t)(kt) * 64) * 2;       \
    __builtin_amdgcn_global_load_lds((glb_void*)(sb_ + vA0), (lds_void*)(size_t)(lb + SA8(b, h)), 16, 0, 0);                                                        \
    __builtin_amdgcn_global_load_lds((glb_void*)(sb_ + vA1), (lds_void*)(size_t)(lb + SA8(b, h) + 8192), 16, 0, 0);                                                 \
  }
#define STAGE_B8(b, h, kt)                                                                       \
  {                                                                                              \
    const char* sb_ = (const char*)Bt + ((size_t)((h) * 64) * ldb + (size_t)(kt) * 64) * 2;      \
    __builtin_amdgcn_global_load_lds((glb_void*)(sb_ + vB0), (lds_void*)(size_t)(lb + SB8(b, h)), 16, 0, 0);                                                        \
    __builtin_amdgcn_global_load_lds((glb_void*)(sb_ + vB1), (lds_void*)(size_t)(lb + SB8(b, h) + 8192), 16, 0, 0);                                                 \
  }
#define LDA8(AT, b, h)                                                                           \
  { _Pragma("unroll") for (int s = 0; s < 4; ++s) AT[s] = *(lds_frag*)(aad[s] + SA8(b, h)); }
#define LDB8(BX, b, h)                                                                           \
  { _Pragma("unroll") for (int nl = 0; nl < 2; ++nl)                                             \
      _Pragma("unroll") for (int s = 0; s < 4; ++s) BX[nl][s] = *(lds_frag*)(bad[s] + ((b) * 2 + (h)) * 16384 + nl * 4096); }
#define MMA8(ai, bj, AT, BX)                                                                     \
  {                                                                                              \
    __builtin_amdgcn_s_setprio(1);                                                               \
    _Pragma("unroll") for (int s = 0; s < 4; ++s)                                                \
      _Pragma("unroll") for (int nl = 0; nl < 2; ++nl)                                           \
        acc[ai][2 * (bj) + nl] = TR ? MFMA32(BX[nl][s], AT[s], acc[ai][2 * (bj) + nl]) : MFMA32(AT[s], BX[nl][s], acc[ai][2 * (bj) + nl]);  \
    __builtin_amdgcn_s_setprio(0);                                                               \
  }
#define LD_RA(X, b, h) LDB8(X, b, h)
#define LD_RB(X, b, h) LDA8(X, b, h)
#define ST_RA(b, h, kt) STAGE_B8(b, h, kt)
#define ST_RB(b, h, kt) STAGE_A8(b, h, kt)
#define MM(ra, rb, XA, XB) MMA8(rb, ra, XB, XA)
  bf16x8 Wf[2][4], X0[4], X1[4];
  const int nt = K >> 6;
  RAW_BARRIER();
  ST_RB(0, 0, 0) ST_RA(0, 0, 0) ST_RB(0, 1, 0) ST_RA(0, 1, 0)
  if (grp == 1) BAR8;
  WAIT_V8(4); BAR8;
  ST_RB(1, 0, 1) ST_RA(1, 0, 1) ST_RB(1, 1, 1)
  WAIT_V8(6); BAR8;
  for (int t = 0; t < nt - 2; t += 2) {
    LD_RB(X0, 0, 0) SCHED8; LD_RA(Wf, 0, 0) ST_RA(1, 1, t + 1)
    WAIT_L8(8); BAR8; WAIT_L8(0); MM(0, 0, Wf, X0) BAR8; SCHED8;
    LD_RB(X1, 0, 1) ST_RB(0, 0, t + 2)
    BAR8; WAIT_L8(0); MM(0, 1, Wf, X1) BAR8;
    LD_RA(Wf, 0, 1) ST_RA(0, 0, t + 2)
    BAR8; WAIT_L8(0); MM(1, 0, Wf, X0) BAR8; SCHED8;
    ST_RB(0, 1, t + 2)
    WAIT_V8(6); BAR8; MM(1, 1, Wf, X1) BAR8;
    LD_RB(X0, 1, 0) SCHED8; LD_RA(Wf, 1, 0) ST_RA(0, 1, t + 2)
    WAIT_L8(8); BAR8; WAIT_L8(0); MM(0, 0, Wf, X0) BAR8; SCHED8;
    LD_RB(X1, 1, 1) ST_RB(1, 0, t + 3)
    BAR8; WAIT_L8(0); MM(0, 1, Wf, X1) BAR8;
    LD_RA(Wf, 1, 1) ST_RA(1, 0, t + 3)
    BAR8; WAIT_L8(0); MM(1, 0, Wf, X0) BAR8; SCHED8;
    ST_RB(1, 1, t + 3)
    WAIT_V8(6); BAR8; MM(1, 1, Wf, X1) BAR8;
  }
  {
    LD_RB(X0, 0, 0) LD_RA(Wf, 0, 0) ST_RA(1, 1, nt - 1)
    BAR8; WAIT_L8(0); MM(0, 0, Wf, X0) BAR8;
    LD_RB(X1, 0, 1) BAR8; WAIT_L8(0); MM(0, 1, Wf, X1) BAR8;
    LD_RA(Wf, 0, 1) WAIT_V8(4); BAR8; WAIT_L8(0); MM(1, 0, Wf, X0) MM(1, 1, Wf, X1) BAR8;
  }
  {
    LD_RB(X0, 1, 0) LD_RA(Wf, 1, 0) WAIT_V8(2); BAR8; WAIT_L8(0); MM(0, 0, Wf, X0) BAR8;
    LD_RB(X1, 1, 1) WAIT_V8(0); BAR8; WAIT_L8(0); MM(0, 1, Wf, X1) BAR8;
    LD_RA(Wf, 1, 1) BAR8; WAIT_L8(0); MM(1, 0, Wf, X0) MM(1, 1, Wf, X1) BAR8;
  }
  if (grp == 0) BAR8;
#undef LD_RA
#undef LD_RB
#undef ST_RA
#undef ST_RB
#undef MM
#undef SA8
#undef SB8
#undef STAGE_A8
#undef STAGE_B8
#undef LDA8
#undef LDB8
#undef MMA8
}

template <int NI>
DI void rowss_partial(f32x16 (&acc)[2][NI], char* smem, float* ss, int stride, int slab, int row0, bool doit) {
  const int tid = otid(), lane = tid & 63, wave = tid >> 6;
  const int r = lane & 31, hh = lane >> 5;
  float* sw = (float*)(smem + 65536) + wave * (64 * 33);
#pragma unroll
  for (int mi = 0; mi < 2; ++mi)
#pragma unroll
    for (int i = 0; i < 16; ++i) {
      float t = 0.f;
#pragma unroll
      for (int ni = 0; ni < NI; ++ni) t += acc[mi][ni][i] * acc[mi][ni][i];
      sw[(mi * 32 + crow(i, hh)) * 33 + r] = t;
    }
  __syncthreads();
  float t = 0.f;
#pragma unroll
  for (int j = 0; j < 32; ++j) t += sw[lane * 33 + j];
  if (doit) ss[(size_t)(row0 + (wave >> 1) * 64 + lane) * stride + slab] = t;
  __syncthreads();
}

DI void phase_prep(const Params& p, char* smem) {
  char* ws = p.ws;
  const int gtid = blockIdx.x * NTHR + threadIdx.x, gthreads = gridDim.x * NTHR;
  const int lane = threadIdx.x & 63;
  const int gwave = gtid >> 6, nwaves = gthreads >> 6;
  u16* U = (u16*)(ws + OFF_R1);
  {
    float4 w[4];
    w[0] = *(const float4*)(p.norm_mix_w + lane * 8);
    w[1] = *(const float4*)(p.norm_mix_w + lane * 8 + 4);
    w[2] = *(const float4*)(p.norm_mix_w + 512 + lane * 8);
    w[3] = *(const float4*)(p.norm_mix_w + 512 + lane * 8 + 4);
    for (int row0 = gwave * 4; row0 < MT; row0 += nwaves * 4) {
      const bool live = row0 < M + 16;
      float4 v[4][4];
      if (live) {
#pragma unroll
        for (int k = 0; k < 4; ++k) {
          const int row = row0 + k;
          const float* src = row < M ? p.x + (size_t)row * 1024 : p.meta + (size_t)(row - M) * 1024;
          v[k][0] = *(const float4*)(src + lane * 8);
          v[k][1] = *(const float4*)(src + lane * 8 + 4);
          v[k][2] = *(const float4*)(src + 512 + lane * 8);
          v[k][3] = *(const float4*)(src + 512 + lane * 8 + 4);
        }
      }
#pragma unroll
      for (int k = 0; k < 4; ++k) {
        u32x4 o0 = {0, 0, 0, 0}, o1 = {0, 0, 0, 0};
        if (live) {
          float ss = 0.f;
#pragma unroll
          for (int q = 0; q < 4; ++q) ss += v[k][q].x * v[k][q].x + v[k][q].y * v[k][q].y + v[k][q].z * v[k][q].z + v[k][q].w * v[k][q].w;
          ss = wave_sum(ss);
          const float rs = rsqrtf(ss * (1.f / 1024.f) + 1e-6f);
          o0[0] = pack2(v[k][0].x * rs * w[0].x, v[k][0].y * rs * w[0].y);
          o0[1] = pack2(v[k][0].z * rs * w[0].z, v[k][0].w * rs * w[0].w);
          o0[2] = pack2(v[k][1].x * rs * w[1].x, v[k][1].y * rs * w[1].y);
          o0[3] = pack2(v[k][1].z * rs * w[1].z, v[k][1].w * rs * w[1].w);
          o1[0] = pack2(v[k][2].x * rs * w[2].x, v[k][2].y * rs * w[2].y);
          o1[1] = pack2(v[k][2].z * rs * w[2].z, v[k][2].w * rs * w[2].w);
          o1[2] = pack2(v[k][3].x * rs * w[3].x, v[k][3].y * rs * w[3].y);
          o1[3] = pack2(v[k][3].z * rs * w[3].z, v[k][3].w * rs * w[3].w);
        }
        *(u32x4*)(U + (size_t)(row0 + k) * 1024 + lane * 8) = o0;
        *(u32x4*)(U + (size_t)(row0 + k) * 1024 + 512 + lane * 8) = o1;
      }
    }
  }
  {
    float2* tr = (float2*)(ws + OFF_TRET);
    for (int idx = gtid; idx < NPOS * 32; idx += gthreads) {
      const int pos = idx >> 5, i = idx & 31;
      const float inv = (float)pow(10000.0, -(double)i / 32.0);
      const float ang = (float)pos * inv;
      tr[idx] = make_float2((float)cos((double)ang), (float)sin((double)ang));
    }
    float2* tm = (float2*)(ws + OFF_TMLA);
    for (int idx = gtid; idx < NPOS * 16; idx += gthreads) {
      const int pos = idx >> 4, i = idx & 15;
      const float inv = (float)pow(10000.0, -(double)i / 16.0);
      const float ang = (float)pos * inv;
      tm[idx] = make_float2((float)cos((double)ang), (float)sin((double)ang));
    }
  }
  {
    const int wave = threadIdx.x >> 6;
    char* sT = smem + wave * 9216;
    int base = 0;
    for (int job = 0; job < 8; ++job) {
      int N, K;
      u16* dst;
      switch (job) {
        case 0: N = NIN; K = 1024; dst = (u16*)(ws + OFF_WIN); break;
        case 1: N = 1024; K = 1024; dst = (u16*)(ws + OFF_WRET); break;
        case 2: N = 768; K = 384; dst = (u16*)(ws + OFF_WUQ); break;
        case 3: N = 1024; K = 256; dst = (u16*)(ws + OFF_WUKV); break;
        case 4: N = 1024; K = 512; dst = (u16*)(ws + OFF_WMLA); break;
        case 5: N = 1024; K = 1024; dst = (u16*)(ws + OFF_WO); break;
        case 6: N = 5632; K = 1024; dst = (u16*)(ws + OFF_WGU); break;
        default: N = 1024; K = DFF; dst = (u16*)(ws + OFF_WD); break;
      }
      const int ntn = N >> 6, ntiles = ntn * (K >> 6);
      int first = gwave - (base % nwaves);
      if (first < 0) first += nwaves;
      for (int tl = first; tl < ntiles; tl += nwaves) {
        const int kt = tl / ntn, n = (tl - kt * ntn) * 64 + lane, k0 = kt * 64;
        const float* src = nullptr;
        int ld = 0;
        const float* scale = nullptr;
        switch (job) {
          case 0: {
            ld = 5792;
            if (n < 3712) src = p.w_in + n;
            else if (n < 5760) src = p.w_in + n + 32;
            else if (n < 5824) {
              const int c = n - 5760;
              if (c < 16) src = p.w_in + 3712 + c;
              else if (c >= 32 && c < 48) src = p.w_in + 3712 + 16 + (c - 32);
            }
          } break;
          case 1: ld = 1024; src = p.w_ret_out + n; scale = p.gn_w; break;
          case 2: {
            ld = 768;
            scale = p.q_norm_w;
            if (n < 512) src = p.w_uq + (n >> 6) * 96 + (n & 63);
            else {
              const int g = (n - 512) >> 6, c = (n - 512) & 63;
              const int half = c >> 5, hsel = (c >> 4) & 1, j = c & 15;
              src = p.w_uq + (2 * g + hsel) * 96 + 64 + half * 16 + j;
            }
          } break;
          case 3: ld = 512; scale = p.kv_norm_w; src = n < 512 ? p.w_uk + n : p.w_uv + (n - 512); break;
          case 4: ld = 1024; src = p.w_mla_out + n; break;
          case 5: ld = 1024; src = p.w_o + n; break;
          case 6: {
            ld = DFF;
            scale = p.norm_ffn_w;
            const int blk = n >> 6, c = n & 63;
            src = c < 32 ? p.w_gate + blk * 32 + c : p.w_up + blk * 32 + (c - 32);
          } break;
          default: ld = 1024; src = p.w_down + n; break;
        }
        float v[64];
#pragma unroll
        for (int j = 0; j < 64; ++j) v[j] = src ? src[(size_t)(k0 + j) * ld] : 0.f;
        if (scale) {
          const float sc = scale[k0 + lane];
#pragma unroll
          for (int j = 0; j < 64; ++j) v[j] *= __shfl(sc, j);
        }
#pragma unroll
        for (int j = 0; j < 32; ++j) *(unsigned*)(sT + lane * 144 + j * 4) = pack2(v[2 * j], v[2 * j + 1]);
#pragma unroll
        for (int q = 0; q < 8; ++q) {
          const int row = q * 8 + (lane >> 3), c = lane & 7;
          const u32x4 o = *(const u32x4*)(sT + row * 144 + c * 16);
          *(u32x4*)(dst + (size_t)((tl - kt * ntn) * 64 + row) * K + k0 + c * 8) = o;
        }
      }
      base += ntiles;
    }
  }
}

DI void phase_proj(const Params& p, char* smem) {
  char* ws = p.ws;
  const u16* U = (const u16*)(ws + OFF_R1);
  const u16* W = (const u16*)(ws + OFF_WIN);
  u16* RQ = (u16*)(ws + OFF_RQ);
  u16* RK = (u16*)(ws + OFF_RK);
  u16* RKT = (u16*)(ws + OFF_RKT);
  u16* RVT = (u16*)(ws + OFF_RVT);
  u16* RG = (u16*)(ws + OFF_RG);
  u16* CQ = (u16*)(ws + OFF_CQ);
  u16* CKV = (u16*)(ws + OFF_CKV);
  u16* KR = (u16*)(ws + OFF_KR);
  u16* GRET = (u16*)(ws + OFF_GRET);
  u16* GMLA = (u16*)(ws + OFF_GMLA);
  float* SSQ = (float*)(ws + OFF_SSQ);
  float* SSKV = (float*)(ws + OFF_SSKV);
  const float2* TR = (const float2*)(ws + OFF_TRET);
  const float2* TM = (const float2*)(ws + OFF_TMLA);
  const int tid = otid(), lane = tid & 63, wave = tid >> 6;
  const int wm = wave >> 1, wn = wave & 1, r = lane & 31, hh = lane >> 5;
  constexpr int NT = NIN / 256;
  constexpr int LIM = 33 * 4 * NT;
  int tfirst = vbid();
  {
    int mt_, nt_;
    while (tfirst < LIM && !tile_map(tfirst, MT / 256, NT, mt_, nt_)) tfirst += gridDim.x;
  }
  bool staged = false;
  for (int t = tfirst, tn = 0; t < LIM; t = tn) {
    int mt, nt;
    tile_map(t, MT / 256, NT, mt, nt);
    const int m0 = mt * 256, n0 = nt * 256;
    const u16 *nA = nullptr, *nB = nullptr;
    {
      int mt2 = 0, nt2 = 0;
      tn = t + gridDim.x;
      while (tn < LIM && !tile_map(tn, MT / 256, NT, mt2, nt2)) tn += gridDim.x;
      if (tn < LIM) { nA = U + (size_t)mt2 * 256 * 1024; nB = W + (size_t)nt2 * 256 * 1024; }
    }
    f32x16 acc[2][4];
#pragma unroll
    for (int mi = 0; mi < 2; ++mi)
#pragma unroll
      for (int ni = 0; ni < 4; ++ni) zero_acc(acc[mi][ni]);
    gemm8<false>(U + (size_t)m0 * 1024, 1024, W + (size_t)n0 * 1024, 1024, 1024, acc, smem);
    const int col0 = n0 + wn * 128;
    const int rowb = m0 + wm * 64;
    if (n0 >= 3072 && n0 < 3712) {
      const bool isq = col0 < 3456;
      const bool iskv = col0 >= 3456 && col0 < 3712;
      rowss_partial<4>(acc, smem, isq ? SSQ : SSKV, 4, isq ? (col0 - 3072) >> 7 : (col0 - 3456) >> 7, m0, isq || iskv);
    }
    if (col0 < 1024) {
      const bool isk = col0 >= 512;
#pragma unroll
      for (int mi = 0; mi < 2; ++mi) {
        float o1[2][16], o2[2][16];
#pragma unroll
        for (int i = 0; i < 16; ++i) {
          const int row = rowb + mi * 32 + crow(i, hh);
          const float2 cs = TR[row_pos(row) * 32 + r];
#pragma unroll
          for (int gi = 0; gi < 2; ++gi) {
            float x1 = acc[mi][2 * gi][i], x2 = acc[mi][2 * gi + 1][i];
            float a = x1 * cs.x - x2 * cs.y, b = x1 * cs.y + x2 * cs.x;
            if (isk) { a *= 0.125f; b *= 0.125f; }
            o1[gi][i] = a; o2[gi][i] = b;
          }
        }
        const int rowm = rowb + mi * 32;
#pragma unroll
        for (int gi = 0; gi < 2; ++gi) {
          const int hc = (col0 & 511) + gi * 64;
          if (rowm < M) {
            u16* dst = (isk ? RK : RQ) + (size_t)(rowm + 4 * hh) * 512 + hc + r;
#pragma unroll
            for (int i = 0; i < 16; ++i) {
              const int ro = (i & 3) + 8 * (i >> 2);
              dst[(size_t)ro * 512] = f2bf(o1[gi][i]);
              dst[(size_t)ro * 512 + 32] = f2bf(o2[gi][i]);
            }
          }
          if (isk) {
            store_tokblk(RKT + ((size_t)(rowm >> 3) * 512 + hc + r) * 8, 512, o1[gi], hh);
            store_tokblk(RKT + ((size_t)(rowm >> 3) * 512 + hc + 32 + r) * 8, 512, o2[gi], hh);
          }
        }
      }
    } else if (col0 < 2048) {
#pragma unroll
      for (int mi = 0; mi < 2; ++mi)
#pragma unroll
        for (int ni = 0; ni < 4; ++ni) {
          float v[16];
#pragma unroll
          for (int i = 0; i < 16; ++i) v[i] = acc[mi][ni][i];
          store_tokblk(RVT + ((size_t)((rowb + mi * 32) >> 3) * 1024 + (col0 - 1024 + ni * 32 + r)) * 8, 1024, v, hh);
        }
    } else if (col0 < 3072) {
      u16* dstb = RG + (col0 - 2048);
#pragma unroll
      for (int mi = 0; mi < 2; ++mi)
#pragma unroll
        for (int i = 0; i < 16; ++i) {
          const int row = rowb + mi * 32 + crow(i, hh);
          if (row < M) {
#pragma unroll
            for (int ni = 0; ni < 4; ++ni) dstb[(size_t)row * 1024 + ni * 32 + r] = f2bf(siluf_(acc[mi][ni][i]));
          }
        }
    } else if (col0 >= 3712 && col0 < 5760) {
      if (m0 < M) {
        const bool isret = col0 < 4736;
        u16* gb = isret ? GRET : GMLA;
        const int cb = (col0 - (isret ? 3712 : 4736)) >> 5;
        const int R = rowb >> 6;
#pragma unroll
        for (int mi = 0; mi < 2; ++mi)
#pragma unroll
          for (int ni = 0; ni < 4; ++ni) {
            u32x4 o0, o1;
            o0[0] = pack2(sigmoidf_(acc[mi][ni][0]), sigmoidf_(acc[mi][ni][1]));
            o0[1] = pack2(sigmoidf_(acc[mi][ni][2]), sigmoidf_(acc[mi][ni][3]));
            o0[2] = pack2(sigmoidf_(acc[mi][ni][4]), sigmoidf_(acc[mi][ni][5]));
            o0[3] = pack2(sigmoidf_(acc[mi][ni][6]), sigmoidf_(acc[mi][ni][7]));
            o1[0] = pack2(sigmoidf_(acc[mi][ni][8]), sigmoidf_(acc[mi][ni][9]));
            o1[1] = pack2(sigmoidf_(acc[mi][ni][10]), sigmoidf_(acc[mi][ni][11]));
            o1[2] = pack2(sigmoidf_(acc[mi][ni][12]), sigmoidf_(acc[mi][ni][13]));
            o1[3] = pack2(sigmoidf_(acc[mi][ni][14]), sigmoidf_(acc[mi][ni][15]));
            u16* d = gb + ((((size_t)R * 32 + cb + ni) * 2 + mi) * 64 + lane) * 16;
            *(u32x4*)d = o0;
            *(u32x4*)(d + 8) = o1;
          }
      }
    } else if (col0 < 3712) {
      const bool isq = col0 < 3456;
      u16* dstb = isq ? CQ + (col0 - 3072) : CKV + (col0 - 3456);
      const int ld = isq ? 384 : 256;
#pragma unroll
      for (int mi = 0; mi < 2; ++mi)
#pragma unroll
        for (int i = 0; i < 16; ++i) {
          const int row = rowb + mi * 32 + crow(i, hh);
#pragma unroll
          for (int ni = 0; ni < 4; ++ni) dstb[(size_t)row * ld + ni * 32 + r] = f2bf(acc[mi][ni][i]);
        }
    } else if (col0 == 5760) {
      if (r < 16) {
#pragma unroll
        for (int mi = 0; mi < 2; ++mi)
#pragma unroll
          for (int i = 0; i < 16; ++i) {
            const int row = rowb + mi * 32 + crow(i, hh);
            const float2 cs = TM[row_pos(row) * 16 + r];
            const float x1 = acc[mi][0][i], x2 = acc[mi][1][i];
            KR[(size_t)row * 32 + r] = f2bf(x1 * cs.x - x2 * cs.y);
            KR[(size_t)row * 32 + 16 + r] = f2bf(x1 * cs.y + x2 * cs.x);
          }
      }
    }
  }
}

DI void phase_ret_incr(const Params& p, char* smem) {
  char* ws = p.ws;
  const u16* RKT = (const u16*)(ws + OFF_RKT);
  const u16* RVT = (const u16*)(ws + OFF_RVT);
  u16* INCR = (u16*)(ws + OFF_INCR);
  const int half = threadIdx.x >> 8;
  smem += half * 51200;
  char* sV = smem;
  char* sK = smem + 32768;
  float* sW = (float*)(smem + 49152);
  const int tid = otid() & 255, lane = tid & 63, wave = tid >> 6;
  const int r = lane & 31, hh = lane >> 5;
  const float LOG2E = 1.4426950408889634f;
  for (int pi = blockIdx.x; pi < 4 * 64 * 4; pi += gridDim.x) {
    const int item = 2 * pi + half;
    const int h = item & 7, c = (item >> 3) & 63, b = item >> 9;
    const int col0 = b * SEQ + c * 128;
    const float lgf2 = -__expf(p.decay_f[h]) * LOG2E, lgb2 = -__expf(p.decay_b[h]) * LOG2E;
    __syncthreads();
    if (tid < 128) {
      sW[tid] = exp2f(lgf2 * (float)(127 - tid));
      sW[128 + tid] = exp2f(lgb2 * (float)tid);
    }
    {
      const int tb0 = col0 >> 3;
      const int ve = tid & 127, vc0 = tid >> 7;
#pragma unroll
      for (int q = 0; q < 8; ++q) {
        const int c_ = vc0 + 2 * q;
        u32x4 v = *(const u32x4*)(RVT + ((size_t)(tb0 + c_) * 1024 + h * 128 + ve) * 8);
        *(u32x4*)(sV + ve * 256 + ((c_ ^ (ve & 15)) << 4)) = v;
      }
      const int kd = tid & 63, kc0 = tid >> 6;
#pragma unroll
      for (int q = 0; q < 4; ++q) {
        const int c_ = kc0 + 4 * q;
        u32x4 v = *(const u32x4*)(RKT + ((size_t)(tb0 + c_) * 512 + h * 64 + kd) * 8);
        *(u32x4*)(sK + kd * 256 + ((c_ ^ (kd & 15)) << 4)) = v;
      }
    }
    __syncthreads();
    f32x16 af[2], ab[2];
    zero_acc(af[0]); zero_acc(af[1]); zero_acc(ab[0]); zero_acc(ab[1]);
#pragma unroll
    for (int s = 0; s < 8; ++s) {
      const int ch = 2 * s + hh;
      const int e = wave * 32 + r;
      const bf16x8 a = *(const bf16x8*)(sV + e * 256 + ((ch ^ (e & 15)) << 4));
      const float4 wf0 = *(const float4*)(sW + ch * 8), wf1 = *(const float4*)(sW + ch * 8 + 4);
      const float4 wb0 = *(const float4*)(sW + 128 + ch * 8), wb1 = *(const float4*)(sW + 128 + ch * 8 + 4);
#pragma unroll
      for (int nb = 0; nb < 2; ++nb) {
        const int d = nb * 32 + r;
        const u32x4 kv = *(const u32x4*)(sK + d * 256 + ((ch ^ (d & 15)) << 4));
        u32x4 kf, kb;
        kf[0] = pack2(bflo(kv[0]) * wf0.x, bfhi(kv[0]) * wf0.y);
        kf[1] = pack2(bflo(kv[1]) * wf0.z, bfhi(kv[1]) * wf0.w);
        kf[2] = pack2(bflo(kv[2]) * wf1.x, bfhi(kv[2]) * wf1.y);
        kf[3] = pack2(bflo(kv[3]) * wf1.z, bfhi(kv[3]) * wf1.w);
        kb[0] = pack2(bflo(kv[0]) * wb0.x, bfhi(kv[0]) * wb0.y);
        kb[1] = pack2(bflo(kv[1]) * wb0.z, bfhi(kv[1]) * wb0.w);
        kb[2] = pack2(bflo(kv[2]) * wb1.x, bfhi(kv[2]) * wb1.y);
        kb[3] = pack2(bflo(kv[3]) * wb1.z, bfhi(kv[3]) * wb1.w);
        af[nb] = MFMA32(a, __builtin_bit_cast(bf16x8, kf), af[nb]);
        ab[nb] = MFMA32(a, __builtin_bit_cast(bf16x8, kb), ab[nb]);
      }
    }
    const int fslot = c <= 62 ? c + 1 : -1;
    const int bslot = c >= 1 ? c - 1 : -1;
#pragma unroll
    for (int nb = 0; nb < 2; ++nb)
#pragma unroll
      for (int i = 0; i < 16; ++i) {
        const int e = wave * 32 + crow(i, hh), d = nb * 32 + r;
        if (fslot >= 0) INCR[((size_t)((0 * 4 + b) * 64 + fslot) * 8 + h) * 8192 + e * 64 + d] = f2bf(af[nb][i]);
        if (bslot >= 0) INCR[((size_t)((1 * 4 + b) * 64 + bslot) * 8 + h) * 8192 + e * 64 + d] = f2bf(ab[nb][i]);
      }
  }
}

DI void phase_ret_scan(const Params& p) {
  unsigned* INCR = (unsigned*)(p.ws + OFF_INCR);
  const int gtid = blockIdx.x * NTHR + threadIdx.x, gthreads = gridDim.x * NTHR;
  const float LOG2E = 1.4426950408889634f;
  for (int idx = gtid; idx < 2 * 4 * 8 * 4096; idx += gthreads) {
    const int pr = idx & 4095, h = (idx >> 12) & 7, b = (idx >> 15) & 3, dir = idx >> 17;
    const float lg2 = -__expf(dir ? p.decay_b[h] : p.decay_f[h]) * LOG2E;
    const float g = exp2f(lg2 * 128.f);
    unsigned* base = INCR + (size_t)(dir * 4 + b) * 64 * 8 * 4096 + (size_t)h * 4096 + pr;
    float s0 = 0.f, s1 = 0.f;
    if (dir) {
      base[(size_t)63 * 8 * 4096] = 0u;
    } else {
      const int e = pr >> 5, d = (pr & 31) * 2;
      const u16* RKT = (const u16*)(p.ws + OFF_RKT);
      const u16* RVT = (const u16*)(p.ws + OFF_RVT);
#pragma unroll
      for (int tb = 0; tb < 2; ++tb) {
        const u32x4 vv = *(const u32x4*)(RVT + ((size_t)((M >> 3) + tb) * 1024 + h * 128 + e) * 8);
        const u32x4 k0 = *(const u32x4*)(RKT + ((size_t)((M >> 3) + tb) * 512 + h * 64 + d) * 8);
        const u32x4 k1 = *(const u32x4*)(RKT + ((size_t)((M >> 3) + tb) * 512 + h * 64 + d + 1) * 8);
#pragma unroll
        for (int j = 0; j < 4; ++j) {
          const float w0 = exp2f(lg2 * (float)(15 - (tb * 8 + 2 * j))), w1 = exp2f(lg2 * (float)(15 - (tb * 8 + 2 * j + 1)));
          s0 += w0 * bflo(vv[j]) * bflo(k0[j]) + w1 * bfhi(vv[j]) * bfhi(k0[j]);
          s1 += w0 * bflo(vv[j]) * bflo(k1[j]) + w1 * bfhi(vv[j]) * bfhi(k1[j]);
        }
      }
      base[0] = pack2(s0, s1);
    }
#pragma unroll 1
    for (int bt = 0; bt < 4; ++bt) {
      unsigned* q = dir ? base + (size_t)(62 - bt * 16) * 8 * 4096 : base + (size_t)(1 + bt * 16) * 8 * 4096;
      const long st = dir ? -(long)(8 * 4096) : (long)(8 * 4096);
      const int cnt = bt == 3 ? 15 : 16;
      unsigned u[16];
#pragma unroll
      for (int n = 0; n < 16; ++n) u[n] = (n < cnt) ? q[n * st] : 0u;
#pragma unroll
      for (int n = 0; n < 16; ++n) {
        s0 = g * s0 + bflo(u[n]); s1 = g * s1 + bfhi(u[n]);
        u[n] = pack2(s0, s1);
      }
#pragma unroll
      for (int n = 0; n < 16; ++n) if (n < cnt) q[n * st] = u[n];
    }
  }
}

DI void phase_ret_out(const Params& p, char* smem) {
  char* ws = p.ws;
  const u16* RQ = (const u16*)(ws + OFF_RQ);
  const u16* RK = (const u16*)(ws + OFF_RK);
  const u16* RVT = (const u16*)(ws + OFF_RVT);
  const u16* ST = (const u16*)(ws + OFF_INCR);
  u16* RG = (u16*)(ws + OFF_RG);
  const int half = threadIdx.x >> 8;
  smem += half * 51200;
  const int tid = otid() & 255, lane = tid & 63, wave = tid >> 6;
  const int r = lane & 31, hh = lane >> 5;
  const float LOG2E = 1.4426950408889634f;
  for (int pi = blockIdx.x; pi < 4 * 64 * 4; pi += gridDim.x) {
    const int item = 2 * pi + half;
    const int h = item & 7, n = (item >> 3) & 63, b = item >> 9;
    const int row0 = b * SEQ + n * 128;
    const float lgf2 = -__expf(p.decay_f[h]) * LOG2E, lgb2 = -__expf(p.decay_b[h]) * LOG2E;
    const int qi = wave * 32 + r;
    bf16x8 qf[4];
#pragma unroll
    for (int s = 0; s < 4; ++s) qf[s] = *(const bf16x8*)(RQ + (size_t)(row0 + qi) * 512 + h * 64 + (2 * s + hh) * 8);
    __syncthreads();
    char* sF = smem;
    char* sB = smem + 16384;
    {
      const int lr = tid >> 3, lc = tid & 7;
      const u16* gf = ST + ((size_t)((0 * 4 + b) * 64 + n) * 8 + h) * 8192;
      const u16* gb = ST + ((size_t)((1 * 4 + b) * 64 + n) * 8 + h) * 8192;
#pragma unroll
      for (int q = 0; q < 4; ++q) {
        const int row = lr + 32 * q;
        const int so = row * 128 + ((lc ^ ((row >> 1) & 7)) << 4);
        *(u32x4*)(sF + so) = *(const u32x4*)(gf + row * 64 + lc * 8);
        *(u32x4*)(sB + so) = *(const u32x4*)(gb + row * 64 + lc * 8);
      }
    }
    __syncthreads();
    f32x16 O[4];
    {
      const float wq = __builtin_amdgcn_exp2f(lgf2 * (float)(qi + 1));
      const float wqb = __builtin_amdgcn_exp2f(lgb2 * (float)(128 - qi));
#pragma unroll
      for (int eb = 0; eb < 4; ++eb) {
        const int e = eb * 32 + r;
        f32x16 t;
        zero_acc(t);
#pragma unroll
        for (int s = 0; s < 4; ++s) {
          const bf16x8 a = *(const bf16x8*)(sF + e * 128 + (((2 * s + hh) ^ ((e >> 1) & 7)) << 4));
          t = MFMA32(a, qf[s], t);
        }
#pragma unroll
        for (int i = 0; i < 16; ++i) O[eb][i] = t[i] * wq;
        zero_acc(t);
#pragma unroll
        for (int s = 0; s < 4; ++s) {
          const bf16x8 a = *(const bf16x8*)(sB + e * 128 + (((2 * s + hh) ^ ((e >> 1) & 7)) << 4));
          t = MFMA32(a, qf[s], t);
        }
#pragma unroll
        for (int i = 0; i < 16; ++i) O[eb][i] += t[i] * wqb;
        __builtin_amdgcn_sched_barrier(0);
      }
    }
    __syncthreads();
    char* sK = smem;
    char* sV = smem + 16384;
    {
      const int lr = tid >> 3, lc = tid & 7;
#pragma unroll
      for (int q = 0; q < 4; ++q) {
        const int row = lr + 32 * q;
        *(u32x4*)(sK + row * 128 + ((lc ^ ((row >> 1) & 7)) << 4)) = *(const u32x4*)(RK + (size_t)(row0 + row) * 512 + h * 64 + lc * 8);
      }
      const int ve = tid & 127, vc0 = tid >> 7;
#pragma unroll
      for (int q = 0; q < 8; ++q) {
        const int c_ = vc0 + 2 * q;
        *(u32x4*)(sV + ve * 256 + ((c_ ^ (ve & 15)) << 4)) = *(const u32x4*)(RVT + ((size_t)((row0 >> 3) + c_) * 1024 + h * 128 + ve) * 8);
      }
    }
    __syncthreads();
    const int r_sw = (r & 0x13) | ((r & 4) << 1) | ((r & 8) >> 1);
#pragma unroll 1
    for (int kb = 0; kb < 4; ++kb) {
      f32x16 S;
      zero_acc(S);
      const int krow = kb * 32 + r_sw;
#pragma unroll
      for (int s = 0; s < 4; ++s) {
        const bf16x8 a = *(const bf16x8*)(sK + krow * 128 + (((2 * s + hh) ^ ((krow >> 1) & 7)) << 4));
        S = MFMA32(a, qf[s], S);
      }
      u32x4 pf[2];
#pragma unroll
      for (int t = 0; t < 2; ++t) {
        float pv[8];
#pragma unroll
        for (int jj = 0; jj < 8; ++jj) {
          const int key = kb * 32 + 16 * t + 8 * hh + jj;
          const int dlt = qi - key;
          const float w = __builtin_amdgcn_exp2f(dlt >= 0 ? lgf2 * (float)dlt : lgb2 * (float)(-dlt));
          pv[jj] = S[8 * t + jj] * w;
        }
        pf[t][0] = pack2(pv[0], pv[1]); pf[t][1] = pack2(pv[2], pv[3]);
        pf[t][2] = pack2(pv[4], pv[5]); pf[t][3] = pack2(pv[6], pv[7]);
      }
#pragma unroll
      for (int t = 0; t < 2; ++t) {
        const int ch = 2 * (2 * kb + t) + hh;
#pragma unroll
        for (int eb = 0; eb < 4; ++eb) {
          const int e = eb * 32 + r;
          const bf16x8 a = *(const bf16x8*)(sV + e * 256 + ((ch ^ (e & 15)) << 4));
          O[eb] = MFMA32(a, __builtin_bit_cast(bf16x8, pf[t]), O[eb]);
        }
        __builtin_amdgcn_sched_barrier(0);
      }
    }
    float sum = 0.f;
#pragma unroll
    for (int eb = 0; eb < 4; ++eb)
#pragma unroll
      for (int i = 0; i < 16; ++i) sum += O[eb][i];
    sum += __shfl_xor(sum, 32);
    const float mu = sum * (1.f / 128.f);
    float var = 0.f;
#pragma unroll
    for (int eb = 0; eb < 4; ++eb)
#pragma unroll
      for (int i = 0; i < 16; ++i) { const float d = O[eb][i] - mu; var += d * d; }
    var += __shfl_xor(var, 32);
    const float rstd = rsqrtf(var * (1.f / 128.f) + 1e-5f);
    u16* grow = RG + (size_t)(row0 + qi) * 1024 + h * 128;
#pragma unroll
    for (int eb = 0; eb < 4; ++eb)
#pragma unroll
      for (int g4 = 0; g4 < 4; ++g4) {
        u32x2* gp = (u32x2*)(grow + eb * 32 + 8 * g4 + 4 * hh);
        const u32x2 gv = *gp;
        const float y0 = (O[eb][4 * g4] - mu) * rstd * bflo(gv[0]);
        const float y1 = (O[eb][4 * g4 + 1] - mu) * rstd * bfhi(gv[0]);
        const float y2 = (O[eb][4 * g4 + 2] - mu) * rstd * bflo(gv[1]);
        const float y3 = (O[eb][4 * g4 + 3] - mu) * rstd * bfhi(gv[1]);
        u32x2 o = {pack2(y0, y1), pack2(y2, y3)};
        *gp = o;
        __builtin_amdgcn_sched_barrier(0);
      }
  }
}

DI void phase_mla_proj(const Params& p, char* smem) {
  char* ws = p.ws;
  const u16* KR = (const u16*)(ws + OFF_KR);
  u16* Q = (u16*)(ws + OFF_Q);
  u16* Kb = (u16*)(ws + OFF_K);
  u16* VT = (u16*)(ws + OFF_VT);
  u16* KM = (u16*)(ws + OFF_KM);
  u16* VM = (u16*)(ws + OFF_VM);
  const float2* TM = (const float2*)(ws + OFF_TMLA);
  const int tid = otid(), lane = tid & 63, wave = tid >> 6;
  const int wm = wave >> 1, wn = wave & 1, r = lane & 31, hh = lane >> 5;
  float* sRS = (float*)(smem + 133120);
  const float QSCALE = 0.10206207261596577f * 1.4426950408889634f;
  bool staged = false;
  for (int t = vbid(); t < 128 * 6; t += gridDim.x) {
    int mt, nt;
    tile_map(t, 128, 6, mt, nt);
    const int m0 = mt * 256, n0 = nt * 128;
    const u16 *nA = nullptr, *nB = nullptr;
    if (t + (int)gridDim.x < 128 * 6) {
      int mt2, nt2;
      tile_map(t + gridDim.x, 128, 6, mt2, nt2);
      nA = (const u16*)(ws + OFF_CQ) + (size_t)mt2 * 256 * 384; nB = (const u16*)(ws + OFF_WUQ) + (size_t)nt2 * 128 * 384;
    }
    RAW_BARRIER();
    if (tid < 256) {
      const float* ss = (const float*)(ws + OFF_SSQ) + (size_t)(m0 + tid) * 4;
      sRS[tid] = rsqrtf((ss[0] + ss[1] + ss[2]) * (1.f / 384.f) + 1e-6f) * QSCALE;
    }
    f32x16 acc[2][2];
#pragma unroll
    for (int mi = 0; mi < 2; ++mi)
#pragma unroll
      for (int ni = 0; ni < 2; ++ni) zero_acc(acc[mi][ni]);
    gemm_core<2>((const u16*)(ws + OFF_CQ) + (size_t)m0 * 384, 384, (const u16*)(ws + OFF_WUQ) + (size_t)n0 * 384, 384, 384, acc, smem, staged, nA, 384, nB, 384);
    staged = nA != nullptr;
    const int col0 = n0 + wn * 64;
    const int rl0 = wm * 64;
    if (col0 < 512) {
      u16* qbase = Q + (size_t)(m0 + rl0 + 4 * hh) * 768 + (col0 >> 6) * 96 + r;
#pragma unroll
      for (int mi = 0; mi < 2; ++mi)
#pragma unroll
        for (int i = 0; i < 16; ++i) {
          const int rlc = mi * 32 + (i & 3) + 8 * (i >> 2);
          const float rs = sRS[rl0 + 4 * hh + rlc];
          qbase[rlc * 768] = f2bf(acc[mi][0][i] * rs);
          qbase[rlc * 768 + 32] = f2bf(acc[mi][1][i] * rs);
        }
    } else {
      const int g = (col0 - 512) >> 6;
      const int head = 2 * g + (r >> 4), j = r & 15;
      u16* qbase = Q + (size_t)(m0 + rl0 + 4 * hh) * 768 + head * 96 + 64 + j;
#pragma unroll
      for (int mi = 0; mi < 2; ++mi)
#pragma unroll
        for (int i = 0; i < 16; ++i) {
          const int rlc = mi * 32 + (i & 3) + 8 * (i >> 2);
          const int rl = rl0 + 4 * hh + rlc;
          const float rs = sRS[rl];
          const float2 cs = TM[row_pos(m0 + rl) * 16 + j];
          const float x1 = acc[mi][0][i] * rs, x2 = acc[mi][1][i] * rs;
          qbase[rlc * 768] = f2bf(x1 * cs.x - x2 * cs.y);
          qbase[rlc * 768 + 16] = f2bf(x1 * cs.y + x2 * cs.x);
        }
    }
  }
  staged = false;
  for (int t = vbid(); t < 128 * 8; t += gridDim.x) {
    int mt, nt;
    tile_map(t, 128, 8, mt, nt);
    const int m0 = mt * 256, n0 = nt * 128;
    const u16 *nA = nullptr, *nB = nullptr;
    if (t + (int)gridDim.x < 128 * 8) {
      int mt2, nt2;
      tile_map(t + gridDim.x, 128, 8, mt2, nt2);
      nA = (const u16*)(ws + OFF_CKV) + (size_t)mt2 * 256 * 256; nB = (const u16*)(ws + OFF_WUKV) + (size_t)nt2 * 128 * 256;
    }
    RAW_BARRIER();
    if (tid < 256) {
      const float* ss = (const float*)(ws + OFF_SSKV) + (size_t)(m0 + tid) * 4;
      sRS[tid] = rsqrtf((ss[0] + ss[1]) * (1.f / 256.f) + 1e-6f);
    }
    f32x16 acc[2][2];
#pragma unroll
    for (int mi = 0; mi < 2; ++mi)
#pragma unroll
      for (int ni = 0; ni < 2; ++ni) zero_acc(acc[mi][ni]);
    gemm_core<2>((const u16*)(ws + OFF_CKV) + (size_t)m0 * 256, 256, (const u16*)(ws + OFF_WUKV) + (size_t)n0 * 256, 256, 256, acc, smem, staged, nA, 256, nB, 256);
    staged = nA != nullptr;
    const int col0 = n0 + wn * 64;
    const int rl0 = wm * 64;
    const int bb = m0 >> 13, key0 = m0 & (SEQ - 1);
    if (col0 < 512) {
      u16* kbase = Kb + ((size_t)(bb * 8 + (col0 >> 6)) * SEQ + key0 + rl0 + 4 * hh) * 96 + r;
#pragma unroll
      for (int mi = 0; mi < 2; ++mi)
#pragma unroll
        for (int i = 0; i < 16; ++i) {
          const int rlc = mi * 32 + (i & 3) + 8 * (i >> 2);
          const float rs = sRS[rl0 + 4 * hh + rlc];
          kbase[rlc * 96] = f2bf(acc[mi][0][i] * rs);
          kbase[rlc * 96 + 32] = f2bf(acc[mi][1][i] * rs);
        }
    } else {
      u16* vhead = VT + (size_t)(bb * 8 + ((col0 - 512) >> 6)) * 64 * SEQ;
#pragma unroll
      for (int mi = 0; mi < 2; ++mi) {
        const int rlm = rl0 + mi * 32;
        const float4 rsa = *(const float4*)(sRS + rlm + 4 * hh), rsb = *(const float4*)(sRS + rlm + 8 + 4 * hh);
        const float4 rsc = *(const float4*)(sRS + rlm + 16 + 4 * hh), rsd = *(const float4*)(sRS + rlm + 24 + 4 * hh);
        const float rsv[16] = {rsa.x, rsa.y, rsa.z, rsa.w, rsb.x, rsb.y, rsb.z, rsb.w, rsc.x, rsc.y, rsc.z, rsc.w, rsd.x, rsd.y, rsd.z, rsd.w};
#pragma unroll
        for (int ni = 0; ni < 2; ++ni) {
          float v[16];
#pragma unroll
          for (int i = 0; i < 16; ++i) v[i] = acc[mi][ni][i] * rsv[i];
          store_tokblk(vhead + ((size_t)((key0 + rlm) >> 3) * 64 + ni * 32 + r) * 8, 64, v, hh);
        }
      }
    }
  }
  {
    const int gtid = blockIdx.x * NTHR + tid, gthreads = gridDim.x * NTHR;
    const u16* CKV = (const u16*)(ws + OFF_CKV);
    const u16* WUKV = (const u16*)(ws + OFF_WUKV);
    const float* SSKV = (const float*)(ws + OFF_SSKV);
    for (int idx = gtid; idx < 64 * 1024; idx += gthreads) {
      const int row = idx >> 10, n = idx & 1023;
      float v = 0.f;
      if (row < 16) {
        const u32x4* a = (const u32x4*)(CKV + (size_t)(M + row) * 256);
        const u32x4* w = (const u32x4*)(WUKV + (size_t)n * 256);
        float acc = 0.f;
        for (int k = 0; k < 32; ++k) {
          const u32x4 av = a[k], wv = w[k];
#pragma unroll
          for (int j = 0; j < 4; ++j) acc += bflo(av[j]) * bflo(wv[j]) + bfhi(av[j]) * bfhi(wv[j]);
        }
        const float* ss = SSKV + (size_t)(M + row) * 4;
        v = acc * rsqrtf((ss[0] + ss[1]) * (1.f / 256.f) + 1e-6f);
      }
      if (n < 512) KM[(size_t)((n >> 6) * 64 + row) * 96 + (n & 63)] = f2bf(v);
      else VM[(size_t)((n - 512) >> 6) * 64 * 64 + ((size_t)(row >> 3) * 64 + ((n - 512) & 63)) * 8 + (row & 7)] = f2bf(v);
    }
  }
  {
    const int gtid = blockIdx.x * NTHR + tid, gthreads = gridDim.x * NTHR;
    const int total = (M + 64) * 8 * 4;
    for (int idx = gtid; idx < total; idx += gthreads) {
      const int c = idx & 3, head = (idx >> 2) & 7, row = idx >> 5;
      const u32x4 v = *(const u32x4*)(KR + (size_t)row * 32 + c * 8);
      if (row < M) {
        const int bb = row >> 13, key = row & (SEQ - 1);
        *(u32x4*)(Kb + ((size_t)(bb * 8 + head) * SEQ + key) * 96 + 64 + c * 8) = v;
      } else {
        *(u32x4*)(KM + (size_t)(head * 64 + (row - M)) * 96 + 64 + c * 8) = v;
      }
    }
  }
}

DI void phase_attn(const Params& p, char* smem) {
  char* ws = p.ws;
  const u16* Q = (const u16*)(ws + OFF_Q);
  const u16* Kb = (const u16*)(ws + OFF_K);
  const u16* VT = (const u16*)(ws + OFF_VT);
  const u16* KM = (const u16*)(ws + OFF_KM);
  const u16* VM = (const u16*)(ws + OFF_VM);
  u16* AO = (u16*)(ws + OFF_AO);
  char* sK0 = smem;
  char* sK1 = smem + 12288;
  char* sV0 = smem + 24576;
  char* sV1 = smem + 32768;
  const int tid = otid(), lane = tid & 63, wave = tid >> 6;
  const int r = lane & 31, hh = lane >> 5;
  const int r_sw = (r & 0x13) | ((r & 4) << 1) | ((r & 8) >> 1);
  const int kw0 = (tid / 12) * 192 + (((tid % 12) ^ (((tid / 12) >> 2) & 3)) << 4);
  const int ci1 = tid + 512;
  const int kw1 = (ci1 / 12) * 192 + (((ci1 % 12) ^ (((ci1 / 12) >> 2) & 3)) << 4);
  const int vw = (tid & 63) * 128 + (((tid >> 6) ^ (((tid & 63) >> 1) & 7)) << 4);
  const bool k2 = tid < 256;
  const int grp = __builtin_amdgcn_readfirstlane(wave) >> 2;
  const int kr0 = r_sw * 192, kr1 = (32 + r_sw) * 192, ksw = (r_sw >> 2) & 3;
  const int vr0 = r * 128, vr1 = (32 + r) * 128, vsw = (r >> 1) & 7;
  const u32x4 ones_u = {0x3F803F80u, 0x3F803F80u, 0x3F803F80u, 0x3F803F80u};
  const bf16x8 ones = __builtin_bit_cast(bf16x8, ones_u);
  for (int item = vbid(); item < 32 * 32; item += gridDim.x) {
    const int qb = item & 31, bh = item >> 5;
    const int b = bh >> 3, h = bh & 7;
    const int qrow = b * SEQ + qb * 256 + wave * 32 + r;
    bf16x8 qf[6];
#pragma unroll
    for (int s = 0; s < 6; ++s) qf[s] = *(const bf16x8*)(Q + (size_t)qrow * 768 + h * 96 + (2 * s + hh) * 8);
    const u16* Kg = Kb + (size_t)bh * SEQ * 96;
    const u16* Vg = VT + (size_t)bh * 64 * SEQ;
    const u16* Kmeta = KM + (size_t)h * 64 * 96;
    const u16* Vmeta = VM + (size_t)h * 64 * 64;
    f32x16 O[2], negm;
    zero_acc(O[0]); zero_acc(O[1]); zero_acc(negm);
    float mrun = 0.f, lrun = 0.f;
    u32x4 rk0, rk1, rv;
#define A_LOADK(T, RK0, RK1)                                                        \
  if ((T) <= 128) {                                                                 \
    const u16* ks_ = (T) == 128 ? Kmeta : Kg + (size_t)(T) * 64 * 96;               \
    RK0 = *(const u32x4*)(ks_ + (size_t)tid * 8);                                   \
    if (k2) RK1 = *(const u32x4*)(ks_ + (size_t)(tid + 512) * 8);                   \
  }
#define A_LOADV(T, RV)                                                              \
  if ((T) <= 128) {                                                                 \
    const u16* vs_ = (T) == 128 ? Vmeta : Vg + (size_t)(T) * 4096;                  \
    RV = *(const u32x4*)(vs_ + (size_t)tid * 8);                                    \
  }
#define A_WRITEK(DST, RK0, RK1) { *(u32x4*)((DST) + kw0) = RK0; if (k2) *(u32x4*)((DST) + kw1) = RK1; }
#define A_WRITEV(DST, RV) { *(u32x4*)((DST) + vw) = RV; }
#define A_QK(S, KB, MREF)                                                           \
  {                                                                                 \
    MREF = mrun;                                                                    \
    _Pragma("unroll") for (int s = 0; s < 6; ++s) {                                 \
      const int co_ = (((2 * s + hh) ^ ksw) << 4);                                  \
      const bf16x8 a0_ = *(const bf16x8*)((KB) + kr0 + co_);                        \
      const bf16x8 a1_ = *(const bf16x8*)((KB) + kr1 + co_);                        \
      if (s == 0) {                                                                 \
        S[0] = MFMA32(a0_, qf[s], negm);                                            \
        S[1] = MFMA32(a1_, qf[s], negm);                                            \
      } else {                                                                      \
        S[0] = MFMA32(a0_, qf[s], S[0]);                                            \
        S[1] = MFMA32(a1_, qf[s], S[1]);                                            \
      }                                                                             \
    }                                                                               \
  }
#define A_SOFTMAX_PV(S, VB, MASKED, MREF, FIRST)                                    \
  {                                                                                 \
    if (MASKED) {                                                                   \
      _Pragma("unroll") for (int i = 0; i < 16; ++i) { if (i >= 8) S[0][i] = -INFINITY; S[1][i] = -INFINITY; }  \
    }                                                                               \
    float mx_ = S[0][0];                                                            \
    _Pragma("unroll") for (int i = 1; i < 16; ++i) mx_ = fmaxf(mx_, S[0][i]);       \
    _Pragma("unroll") for (int i = 0; i < 16; ++i) mx_ = fmaxf(mx_, S[1][i]);       \
    mx_ = fmaxf(mx_, __shfl_xor(mx_, 32));                                          \
    const float d_ = MREF - mrun;                                                   \
    const float cand_ = mx_ + d_;                                                   \
    const bool upd_ = (FIRST) || cand_ > 8.f;                                       \
    if (__builtin_amdgcn_ballot_w64(upd_ || d_ != 0.f) != 0) {                      \
      const float mnew_ = upd_ ? mrun + cand_ : mrun;                               \
      const float shift_ = MREF - mnew_;                                            \
      const float alpha_ = (FIRST) ? 1.f : __builtin_amdgcn_exp2f(mrun - mnew_);    \
      mrun = mnew_;                                                                 \
      _Pragma("unroll") for (int i = 0; i < 16; ++i) {                              \
        O[0][i] *= alpha_; O[1][i] *= alpha_;                                       \
        S[0][i] += shift_; S[1][i] += shift_;                                       \
      }                                                                             \
      lrun *= alpha_;                                                               \
      _Pragma("unroll") for (int i = 0; i < 16; ++i) negm[i] = -mnew_;              \
    }                                                                               \
    _Pragma("unroll") for (int sp = 0; sp < 4; ++sp) {                              \
      const int mb = sp >> 1, t_ = sp & 1;                                          \
      u32x4 pf_;                                                                    \
      float e_[8];                                                                  \
      _Pragma("unroll") for (int q = 0; q < 8; ++q) { e_[q] = __builtin_amdgcn_exp2f(S[mb][8 * t_ + q]); lrun += e_[q]; }  \
      pf_[0] = pack2(e_[0], e_[1]); pf_[1] = pack2(e_[2], e_[3]);                   \
      pf_[2] = pack2(e_[4], e_[5]); pf_[3] = pack2(e_[6], e_[7]);                   \
      const int co_ = (((2 * sp + hh) ^ vsw) << 4);                                 \
      const bf16x8 v0_ = *(const bf16x8*)((VB) + vr0 + co_);                        \
      const bf16x8 v1_ = *(const bf16x8*)((VB) + vr1 + co_);                        \
      const bf16x8 pb_ = __builtin_bit_cast(bf16x8, pf_);                           \
      O[0] = MFMA32(v0_, pb_, O[0]);                                                \
      O[1] = MFMA32(v1_, pb_, O[1]);                                                \
    }                                                                               \
  }
#define A_STEP(J, SCUR, MCUR, SNEXT, MNEXT, KW, VW, KR, VR, RK0, RK1, RV)           \
  {                                                                                 \
    A_WRITEK(KW, RK0, RK1)                                                          \
    A_LOADK((J) + 3, RK0, RK1)                                                      \
    __builtin_amdgcn_sched_barrier(0);                                              \
    __builtin_amdgcn_s_setprio(1);                                                  \
    A_QK(SNEXT, KR, MNEXT)                                                          \
    __builtin_amdgcn_s_setprio(0);                                                  \
    RAW_BARRIER();                                                                  \
    A_WRITEV(VW, RV)                                                                \
    A_LOADV((J) + 2, RV)                                                            \
    __builtin_amdgcn_sched_barrier(0);                                              \
    A_SOFTMAX_PV(SCUR, VR, false, MCUR, (J) == 0)                                   \
    RAW_BARRIER();                                                                  \
  }
    __syncthreads();
    A_LOADK(0, rk0, rk1) A_LOADV(0, rv)
    A_WRITEK(sK0, rk0, rk1) A_WRITEV(sV0, rv)
    A_LOADK(1, rk0, rk1)
    A_WRITEK(sK1, rk0, rk1)
    A_LOADK(2, rk0, rk1) A_LOADV(1, rv)
    __syncthreads();
    f32x16 SA[2], SB[2];
    float mrefA, mrefB;
    A_QK(SA, sK0, mrefA)
    RAW_BARRIER();
    if (grp == 1) __builtin_amdgcn_s_barrier();
    for (int j = 0; j < 128; j += 2) {
      A_STEP(j, SA, mrefA, SB, mrefB, sK0, sV1, sK1, sV0, rk0, rk1, rv)
      A_STEP(j + 1, SB, mrefB, SA, mrefA, sK1, sV0, sK0, sV1, rk0, rk1, rv)
    }
    RAW_BARRIER();
    A_SOFTMAX_PV(SA, sV0, true, mrefA, false)
    if (grp == 0) RAW_BARRIER();
#undef A_LOADK
#undef A_LOADV
#undef A_WRITEK
#undef A_WRITEV
#undef A_QK
#undef A_SOFTMAX_PV
#undef A_STEP
    lrun += __shfl_xor(lrun, 32);
    const float inv = 1.f / lrun;
    u16* dst = AO + (size_t)qrow * 512 + h * 64;
#pragma unroll
    for (int dvb = 0; dvb < 2; ++dvb)
#pragma unroll
      for (int g4 = 0; g4 < 4; ++g4) {
        u32x2 o = {pack2(O[dvb][4 * g4] * inv, O[dvb][4 * g4 + 1] * inv), pack2(O[dvb][4 * g4 + 2] * inv, O[dvb][4 * g4 + 3] * inv)};
        *(u32x2*)(dst + dvb * 32 + 8 * g4 + 4 * hh) = o;
      }
  }
}

DI void phase_merge(const Params& p, char* smem) {
  char* ws = p.ws;
  const u16* YR = (const u16*)(ws + OFF_RG);
  const u16* AO = (const u16*)(ws + OFF_AO);
  const u16* GRET = (const u16*)(ws + OFF_GRET);
  const u16* GMLA = (const u16*)(ws + OFF_GMLA);
  const u16* WRET = (const u16*)(ws + OFF_WRET);
  const u16* WMLA = (const u16*)(ws + OFF_WMLA);
  u16* MG = (u16*)(ws + OFF_MG);
  for (int t = vbid(); t < 128 * 4; t += gridDim.x) {
    int mt, nt;
    tile_map(t, 128, 4, mt, nt);
    const int m0 = mt * 256, n0 = nt * 256;
    f32x16 acc[2][4];
#pragma unroll
    for (int mi = 0; mi < 2; ++mi)
#pragma unroll
      for (int ni = 0; ni < 4; ++ni) zero_acc(acc[mi][ni]);
    gemm8<false>(YR + (size_t)m0 * 1024, 1024, WRET + (size_t)n0 * 1024, 1024, 1024, acc, smem);
    __builtin_amdgcn_sched_barrier(0);
    {
      const int tid = otid(), lane = tid & 63, wave = tid >> 6;
      const size_t gbase = ((size_t)((m0 + (wave >> 1) * 64) >> 6) * 32 + ((n0 + (wave & 1) * 128) >> 5)) * 2;
#pragma unroll
      for (int mi = 0; mi < 2; ++mi, __builtin_amdgcn_sched_barrier(0))
#pragma unroll
        for (int np = 0; np < 2; ++np) {
#pragma unroll
          for (int nq = 0; nq < 2; ++nq) {
            const int ni = 2 * np + nq;
            const size_t go = ((gbase + (size_t)ni * 2 + mi) * 64 + lane) * 16;
            const u32x4 g0 = *(const u32x4*)(GRET + go), g1 = *(const u32x4*)(GRET + go + 8);
            const u32x4 h0 = *(const u32x4*)(GMLA + go), h1 = *(const u32x4*)(GMLA + go + 8);
#pragma unroll
            for (int i = 0; i < 16; ++i) {
              const unsigned gu = i < 8 ? g0[i >> 1] : g1[(i - 8) >> 1];
              const unsigned hu = i < 8 ? h0[i >> 1] : h1[(i - 8) >> 1];
              const float gr = (i & 1) ? bfhi(gu) : bflo(gu);
              const float gm = fmaxf((i & 1) ? bfhi(hu) : bflo(hu), 1e-20f);
              acc[mi][ni][i] *= gr * __builtin_amdgcn_rcpf(gm);
            }
          }
        }
    }
    gemm_core<4>(AO + (size_t)m0 * 512, 512, WMLA + (size_t)n0 * 512, 512, 512, acc, smem);
    __builtin_amdgcn_sched_barrier(0);
    {
      const int tid = otid(), lane = tid & 63, wave = tid >> 6;
      const int wm = wave >> 1, wn = wave & 1, r = lane & 31, hh = lane >> 5;
      const size_t gbase = ((size_t)((m0 + wm * 64) >> 6) * 32 + ((n0 + wn * 128) >> 5)) * 2;
#pragma unroll
      for (int mi = 0; mi < 2; ++mi, __builtin_amdgcn_sched_barrier(0))
#pragma unroll
        for (int np = 0; np < 2; ++np) {
#pragma unroll
          for (int nq = 0; nq < 2; ++nq) {
            const int ni = 2 * np + nq;
            const size_t go = ((gbase + (size_t)ni * 2 + mi) * 64 + lane) * 16;
            const u32x4 h0 = *(const u32x4*)(GMLA + go), h1 = *(const u32x4*)(GMLA + go + 8);
            u16* mrow = MG + (size_t)(m0 + wm * 64 + mi * 32 + 4 * hh) * 1024 + n0 + wn * 128 + ni * 32 + r;
#pragma unroll
            for (int i = 0; i < 16; ++i) {
              const unsigned hu = i < 8 ? h0[i >> 1] : h1[(i - 8) >> 1];
              const float gm = fmaxf((i & 1) ? bfhi(hu) : bflo(hu), 1e-20f);
              mrow[(size_t)((i & 3) + 8 * (i >> 2)) * 1024] = f2bf(gm * acc[mi][ni][i]);
            }
          }
        }
    }
  }
}

DI void phase_wo(const Params& p, char* smem) {
  char* ws = p.ws;
  const u16* MG = (const u16*)(ws + OFF_MG);
  const u16* WO = (const u16*)(ws + OFF_WO);
  u16* H1B = (u16*)(ws + OFF_H1B);
  float* SS1 = (float*)(ws + OFF_SS1);
  const int tid = otid(), lane = tid & 63, wave = tid >> 6;
  const int wm = wave >> 1, wn = wave & 1, r = lane & 31, hh = lane >> 5;
  bool staged = false;
  for (int t = vbid(); t < 128 * 4; t += gridDim.x) {
    int mt, nt;
    tile_map(t, 128, 4, mt, nt);
    const int m0 = mt * 256, n0 = nt * 256;
    const u16 *nA = nullptr, *nB = nullptr;
    if (t + (int)gridDim.x < 128 * 4) {
      int mt2, nt2;
      tile_map(t + gridDim.x, 128, 4, mt2, nt2);
      nA = MG + (size_t)mt2 * 256 * 1024; nB = WO + (size_t)nt2 * 256 * 1024;
    }
    f32x16 acc[2][4];
#pragma unroll
    for (int mi = 0; mi < 2; ++mi)
#pragma unroll
      for (int ni = 0; ni < 4; ++ni) zero_acc(acc[mi][ni]);
    gemm8<false>(MG + (size_t)m0 * 1024, 1024, WO + (size_t)n0 * 1024, 1024, 1024, acc, smem);
    const int col0 = n0 + wn * 128;
#pragma unroll
    for (int mi = 0; mi < 2; ++mi) {
#pragma unroll
      for (int i = 0; i < 16; ++i) {
        const int row = m0 + wm * 64 + mi * 32 + crow(i, hh);
#pragma unroll
        for (int ni = 0; ni < 4; ++ni) {
          const size_t o = (size_t)row * 1024 + col0 + ni * 32 + r;
          const float v = p.x[o] + acc[mi][ni][i];
          acc[mi][ni][i] = v;
          H1B[o] = f2bf(v);
        }
      }
      __builtin_amdgcn_sched_barrier(0);
    }
    rowss_partial<4>(acc, smem, SS1, 8, col0 >> 7, m0, true);
  }
}

DI void phase_gu(const Params& p, char* smem) {
  char* ws = p.ws;
  const u16* H1B = (const u16*)(ws + OFF_H1B);
  const u16* WGU = (const u16*)(ws + OFF_WGU);
  const float* SS1 = (const float*)(ws + OFF_SS1);
  u16* ACT = (u16*)(ws + OFF_ACT);
  float* sRS = (float*)(smem + 133120);
  const int tid = otid(), lane = tid & 63, wave = tid >> 6;
  const int wm = wave >> 1, wn = wave & 1, r = lane & 31, hh = lane >> 5;
  constexpr int NT = 5632 / 256;
  bool staged = false;
  for (int t = vbid(); t < 128 * NT; t += gridDim.x) {
    int mt, nt;
    tile_map(t, 128, NT, mt, nt);
    const int m0 = mt * 256, n0 = nt * 256;
    const u16 *nA = nullptr, *nB = nullptr;
    if (t + (int)gridDim.x < 128 * NT) {
      int mt2, nt2;
      tile_map(t + gridDim.x, 128, NT, mt2, nt2);
      nA = H1B + (size_t)mt2 * 256 * 1024; nB = WGU + (size_t)nt2 * 256 * 1024;
    }
    RAW_BARRIER();
    if (tid < 256) {
      const float4 a = *(const float4*)(SS1 + (size_t)(m0 + tid) * 8), b = *(const float4*)(SS1 + (size_t)(m0 + tid) * 8 + 4);
      sRS[tid] = rsqrtf((a.x + a.y + a.z + a.w + b.x + b.y + b.z + b.w) * (1.f / 1024.f) + 1e-6f);
    }
    f32x16 acc[2][4];
#pragma unroll
    for (int mi = 0; mi < 2; ++mi)
#pragma unroll
      for (int ni = 0; ni < 4; ++ni) zero_acc(acc[mi][ni]);
    gemm8<true>(H1B + (size_t)m0 * 1024, 1024, WGU + (size_t)n0 * 1024, 1024, 1024, acc, smem);
    const int col0 = n0 + wn * 128;
#pragma unroll
    for (int mi = 0; mi < 2; ++mi) {
      const int rl = wm * 64 + mi * 32 + r;
      const float rs = sRS[rl];
      u16* arow = ACT + (size_t)(m0 + rl) * DFF + (col0 >> 1);
#pragma unroll
      for (int gi = 0; gi < 2; ++gi) {
        float v[16];
#pragma unroll
        for (int i = 0; i < 16; ++i) v[i] = siluf_(acc[mi][2 * gi][i] * rs) * (acc[mi][2 * gi + 1][i] * rs);
        store_block32(arow + gi * 32, v, hh);
      }
    }
  }
}

DI void phase_down(const Params& p, char* smem) {
  char* ws = p.ws;
  const u16* ACT = (const u16*)(ws + OFF_ACT);
  const u16* WD = (const u16*)(ws + OFF_WD);
  const u16* H1B = (const u16*)(ws + OFF_H1B);
  const int tid = otid(), lane = tid & 63, wave = tid >> 6;
  const int wm = wave >> 1, wn = wave & 1, r = lane & 31, hh = lane >> 5;
  bool staged = false;
  for (int t = vbid(); t < 128 * 4; t += gridDim.x) {
    int mt, nt;
    tile_map(t, 128, 4, mt, nt);
    const int m0 = mt * 256, n0 = nt * 256;
    const u16 *nA = nullptr, *nB = nullptr;
    if (t + (int)gridDim.x < 128 * 4) {
      int mt2, nt2;
      tile_map(t + gridDim.x, 128, 4, mt2, nt2);
      nA = ACT + (size_t)mt2 * 256 * DFF; nB = WD + (size_t)nt2 * 256 * DFF;
    }
    f32x16 acc[2][4];
#pragma unroll
    for (int mi = 0; mi < 2; ++mi)
#pragma unroll
      for (int ni = 0; ni < 4; ++ni) zero_acc(acc[mi][ni]);
    gemm8<false>(ACT + (size_t)m0 * DFF, DFF, WD + (size_t)n0 * DFF, DFF, DFF, acc, smem);
    const int col0 = n0 + wn * 128;
#pragma unroll
    for (int mi = 0; mi < 2; ++mi) {
#pragma unroll
      for (int i = 0; i < 16; ++i) {
        const int row = m0 + wm * 64 + mi * 32 + crow(i, hh);
#pragma unroll
        for (int ni = 0; ni < 4; ++ni) {
          const size_t o = (size_t)row * 1024 + col0 + ni * 32 + r;
          p.out[o] = bf2f(H1B[o]) + acc[mi][ni][i];
        }
      }
      __builtin_amdgcn_sched_barrier(0);
    }
  }
}

DI void phase_final(const Params& p) {
  const int gtid = blockIdx.x * NTHR + threadIdx.x, gthreads = gridDim.x * NTHR;
  const int lane = threadIdx.x & 63;
  const int gwave = gtid >> 6, nwaves = gthreads >> 6;
  float4 w[4];
#pragma unroll
  for (int q = 0; q < 4; ++q) w[q] = *(const float4*)(p.norm_final_w + q * 256 + lane * 4);
  for (int row0 = gwave * 4; row0 < M; row0 += nwaves * 4) {
    float4 v[4][4];
#pragma unroll
    for (int k = 0; k < 4; ++k)
#pragma unroll
      for (int q = 0; q < 4; ++q) v[k][q] = *(const float4*)(p.out + (size_t)(row0 + k) * 1024 + q * 256 + lane * 4);
#pragma unroll
    for (int k = 0; k < 4; ++k) {
      float ss = 0.f;
#pragma unroll
      for (int q = 0; q < 4; ++q) ss += v[k][q].x * v[k][q].x + v[k][q].y * v[k][q].y + v[k][q].z * v[k][q].z + v[k][q].w * v[k][q].w;
      ss = wave_sum(ss);
      const float rs = rsqrtf(ss * (1.f / 1024.f) + 1e-6f);
#pragma unroll
      for (int q = 0; q < 4; ++q) {
        float4 o = make_float4(v[k][q].x * rs * w[q].x, v[k][q].y * rs * w[q].y, v[k][q].z * rs * w[q].z, v[k][q].w * rs * w[q].w);
        *(float4*)(p.out + (size_t)(row0 + k) * 1024 + q * 256 + lane * 4) = o;
      }
    }
  }
}

#define XB_TMO      128
#define XB_XCNT(j)  (256  + 64 * (j))
#define XB_XSUB(j)  (1280 + 64 * (j))
#define XB_XGEN(j)  (2304 + 64 * (j))
#define XB_TOP      3328
#define XB_TOPGEN   3392
#define XCD_BAR_WORDS 3456
#define XB_SPIN_CAP (1u << 18)
#define LAS __attribute__((address_space(3)))

DI unsigned xb_ld(unsigned* p)              { return __hip_atomic_load(p, __ATOMIC_RELAXED, __HIP_MEMORY_SCOPE_AGENT); }
DI unsigned xb_add(unsigned* p, unsigned v) { return __hip_atomic_fetch_add(p, v, __ATOMIC_RELAXED, __HIP_MEMORY_SCOPE_AGENT); }
DI unsigned xb_xcc_id() { return (unsigned)__builtin_amdgcn_s_getreg((3 << 11) | 20) & 0xFu; }
#define XB_SPIN(cond, bar) do { unsigned _sp = 0; while (cond) { __builtin_amdgcn_s_sleep(1); \
    if ((++_sp & 255u) == 0u) { if (xb_ld(&(bar)[XB_TMO])) break; if (_sp > XB_SPIN_CAP) { atomicAdd(&(bar)[XB_TMO], 1u); break; } } } } while (0)

struct XcdBarrier {
    unsigned* bar; unsigned x;
    volatile LAS unsigned* st;
};

DI XcdBarrier xcd_barrier_post(unsigned* bar, volatile LAS unsigned* st) {
    XcdBarrier b; b.bar = bar; b.x = xb_xcc_id(); b.st = st;
    if (threadIdx.x == 0) (void)xb_add(&bar[XB_XCNT(b.x)], 1u);
    return b;
}
DI void xcd_barrier_complete(unsigned* bar, unsigned x, unsigned& nloc, unsigned& nx) {
    const unsigned G = gridDim.x * gridDim.y * gridDim.z;
    unsigned sum, cnt, mine, sp = 0u;
    for (;;) {
        sum = 0u; cnt = 0u; mine = 0u;
#pragma unroll
        for (unsigned j = 0; j < 16; ++j) { const unsigned c = xb_ld(&bar[XB_XCNT(j)]); sum += c; cnt += (c > 0u) ? 1u : 0u; mine = (j == x) ? c : mine; }
        if (sum == G) break;
        __builtin_amdgcn_s_sleep(1);
        if ((++sp & 255u) == 0u) { if (xb_ld(&bar[XB_TMO])) break; if (sp > XB_SPIN_CAP) { atomicAdd(&bar[XB_TMO], 1u); break; } }
    }
    nloc = mine > 0u ? mine : 1u; nx = cnt > 0u ? cnt : 1u;
}

DI void xcd_barrier(const XcdBarrier& b) {
    asm volatile("s_waitcnt vmcnt(0)" ::: "memory");
    __syncthreads();
    if (threadIdx.x == 0) {
        unsigned* bar = b.bar;
        __builtin_amdgcn_s_waitcnt(0);
        unsigned nloc = b.st[0], nx = b.st[1];
        if (nloc == 0u) { xcd_barrier_complete(bar, b.x, nloc, nx); b.st[0] = nloc; b.st[1] = nx; }
        const unsigned old = xb_add(&bar[XB_XSUB(b.x)], 1u);
        const unsigned gen = old / nloc;
        if (old + 1u == (gen + 1u) * nloc) {
            __builtin_amdgcn_fence(__ATOMIC_RELEASE, "agent");
            asm volatile("s_waitcnt vmcnt(0)" ::: "memory");
            const unsigned og = xb_add(&bar[XB_TOP], 1u);
            const unsigned tg = og / nx;
            if (og + 1u == (tg + 1u) * nx) xb_add(&bar[XB_TOPGEN], 1u);
            else XB_SPIN(xb_ld(&bar[XB_TOPGEN]) == tg, bar);
            __builtin_amdgcn_fence(__ATOMIC_ACQUIRE, "agent");
            xb_add(&bar[XB_XGEN(b.x)], 1u);
            asm volatile("s_waitcnt vmcnt(0)" ::: "memory");
        } else {
            XB_SPIN(xb_ld(&bar[XB_XGEN(b.x)]) == gen, bar);
            __builtin_amdgcn_fence(__ATOMIC_ACQUIRE, "agent");
            asm volatile("s_waitcnt vmcnt(0)" ::: "memory");
        }
    }
    __syncthreads();
}

DI void grid_barrier(unsigned* ctr, unsigned target) {
  asm volatile("s_waitcnt vmcnt(0)" ::: "memory");
  __syncthreads();
  if (threadIdx.x == 0) {
    __builtin_amdgcn_fence(__ATOMIC_RELEASE, "agent");
    asm volatile("s_waitcnt vmcnt(0)" ::: "memory");
    __hip_atomic_fetch_add(ctr, 1u, __ATOMIC_RELAXED, __HIP_MEMORY_SCOPE_AGENT);
    while (__hip_atomic_load(ctr, __ATOMIC_RELAXED, __HIP_MEMORY_SCOPE_AGENT) < target) __builtin_amdgcn_s_sleep(2);
    __builtin_amdgcn_fence(__ATOMIC_ACQUIRE, "agent");
    asm volatile("s_waitcnt vmcnt(0)" ::: "memory");
  }
  __syncthreads();
}

constexpr int NPHASE = 12;

#if MULTI_LAUNCH
#define PH_ARGS , int ph_lo, int ph_hi
#define RUN_PHASE(k, call) if (ph_lo <= (k) && (k) < ph_hi) { call; }
#else
#define PH_ARGS
#define RUN_PHASE(k, call) { call; if ((k) + 1 < NPHASE) { XcdBarrier b_; b_.bar = (unsigned*)(p.ws + OFF_BAR); b_.x = xb_xcc_id(); b_.st = (volatile LAS unsigned*)&xb_words; xcd_barrier(b_); } }
#endif

__global__ void __launch_bounds__(512, 2) mega(Params p PH_ARGS) {
  __shared__ __attribute__((aligned(16))) char smem[134144];
  __shared__ uint4 xb_words;
  if (threadIdx.x == 0) xb_words = make_uint4(0u, 0u, 0u, 0u);
  __syncthreads();
  if (p.ws == nullptr) cg::this_grid().sync();
  (void)xcd_barrier_post((unsigned*)(p.ws + OFF_BAR), (volatile LAS unsigned*)&xb_words);
  RUN_PHASE(0, phase_prep(p, smem))
  RUN_PHASE(1, phase_proj(p, smem))
  RUN_PHASE(2, phase_ret_incr(p, smem))
  RUN_PHASE(3, phase_ret_scan(p))
  RUN_PHASE(4, phase_ret_out(p, smem))
  RUN_PHASE(5, phase_mla_proj(p, smem))
  RUN_PHASE(6, phase_attn(p, smem))
  RUN_PHASE(7, phase_merge(p, smem))
  RUN_PHASE(8, phase_wo(p, smem))
  RUN_PHASE(9, phase_gu(p, smem))
  RUN_PHASE(10, phase_down(p, smem))
  RUN_PHASE(11, phase_final(p))
}

extern "C" void kernel_launch(void* const* d_in, const int* in_sizes, int n_in, void* d_out, int out_size,
                              void* d_ws, size_t ws_size, hipStream_t stream) {
  static int grid_blocks = 0;
  if (!grid_blocks) {
    int dev = 0, cus = 0, per_cu = 0;
    hipGetDevice(&dev);
    hipDeviceGetAttribute(&cus, hipDeviceAttributeMultiprocessorCount, dev);
    hipOccupancyMaxActiveBlocksPerMultiprocessor(&per_cu, mega, NTHR, 0);
    if (per_cu > 1) per_cu = 1;
    if (per_cu < 1) per_cu = 1;
    grid_blocks = cus * per_cu;
  }
  Params p{};
  p.x = (const float*)d_in[0]; p.meta = (const float*)d_in[1]; p.norm_mix_w = (const float*)d_in[2];
  p.w_in = (const float*)d_in[3]; p.decay_f = (const float*)d_in[4]; p.decay_b = (const float*)d_in[5];
  p.gn_w = (const float*)d_in[6]; p.w_ret_out = (const float*)d_in[7]; p.q_norm_w = (const float*)d_in[8];
  p.w_uq = (const float*)d_in[9]; p.kv_norm_w = (const float*)d_in[10]; p.w_uk = (const float*)d_in[11];
  p.w_uv = (const float*)d_in[12]; p.w_mla_out = (const float*)d_in[13]; p.w_o = (const float*)d_in[14];
  p.norm_ffn_w = (const float*)d_in[15]; p.w_gate = (const float*)d_in[16]; p.w_up = (const float*)d_in[17];
  p.w_down = (const float*)d_in[18]; p.norm_final_w = (const float*)d_in[19];
  p.out = (float*)d_out;
  p.ws = (char*)d_ws;
  if (ws_size < WS_END) { fprintf(stderr, "workspace too small: %zu < %zu\n", ws_size, (size_t)WS_END); return; }
#if MULTI_LAUNCH
  for (int ph = 0; ph < NPHASE; ++ph) hipLaunchKernelGGL(mega, dim3(grid_blocks), dim3(NTHR), 0, stream, p, ph, ph + 1);
#else
  hipMemsetAsync((char*)d_ws + OFF_BAR, 0, 16384, stream);
  void* args[] = {&p};
  hipError_t e = hipLaunchCooperativeKernel((void*)mega, dim3(grid_blocks), dim3(NTHR), args, 0, stream);
  if (e != hipSuccess) fprintf(stderr, "cooperative launch failed: %s (grid %d)\n", hipGetErrorString(e), grid_blocks);
#endif
}
```
